# Optimizing an MI355X kernel written in HIP

```python
import jax, jax.numpy as jnp
from jax import lax
import numpy as np

D_MODEL = 1024
BATCH = 8
SEQ = 4096
DEPTH = 1
DEC_BATCH = 32
DEC_SEQ = 32
PAST_LEN = 2048

CHUNK = 64
N_PAST_CHUNKS = 8
N_BAND = N_PAST_CHUNKS + 1
D_CONV = D_MODEL // 2
D_ATT = D_MODEL - D_CONV
HEAD_DIM = 64
N_HEADS = D_ATT // HEAD_DIM
CONV_W = 3
REL_CLIP = 128
N_REL = 2 * REL_CLIP + 1
D_PLE = 256
EPS = 1e-6
SPLITS = (D_CONV, D_CONV, D_CONV, D_CONV, D_ATT, D_ATT, D_ATT, D_ATT)
D_IN = sum(SPLITS)

kernel_name = "hybrid_conv_chunkattn_streaming_step"


def rmsnorm(x, g):
    xf = x.astype(jnp.float32)
    r = lax.rsqrt(jnp.mean(xf * xf, axis=-1, keepdims=True) + EPS)
    return (xf * r * g.astype(jnp.float32)).astype(x.dtype)


def project_in(xn, w_in):
    z = xn @ w_in
    offsets = [int(o) for o in np.cumsum(SPLITS)[:-1]]
    return jnp.split(z, offsets, axis=-1)


def short_conv(u_ext, w, length):
    out = w[0] * u_ext[:, 0:length]
    for t in range(1, CONV_W):
        out = out + w[t] * u_ext[:, t:t + length]
    return out


def band_attention(q, k, v, rel, valid, rel_bias):
    bias = rel_bias[:, jnp.clip(rel, -REL_CLIP, REL_CLIP) + REL_CLIP]
    s = jnp.einsum('...qhd,...khd->...hqk', q, k).astype(jnp.float32) * (HEAD_DIM ** -0.5)
    s = s + bias.astype(jnp.float32)
    if valid is not None:
        s = jnp.where(valid, s, -1e30)
    pr = jax.nn.softmax(s, axis=-1).astype(v.dtype)
    return jnp.einsum('...hqk,...khd->...qhd', pr, v)


def merge_out(yc, ya, norm_conv, norm_att, w_out):
    y = jnp.concatenate([rmsnorm(yc, norm_conv), rmsnorm(ya, norm_att)], axis=-1)
    return y @ w_out


def per_layer_embed(x, p, ple_norm, w_ple_gate, w_ple_proj):
    gate = jax.nn.sigmoid(rmsnorm(x, ple_norm) @ w_ple_gate)
    return x + gate * (p @ w_ple_proj)


def prompt_layer(x, p, norm_in, w_in, conv_w, rel_bias, norm_conv, norm_att, w_out,
                 ple_norm, w_ple_gate, w_ple_proj):
    B, S, _ = x.shape
    xn = rmsnorm(x, norm_in)
    h, bg, cg, zc, q, k, v, za = project_in(xn, w_in)
    u = cg * h
    u_ext = jnp.pad(u, ((0, 0), (CONV_W - 1, 0), (0, 0)))
    yc = bg * short_conv(u_ext, conv_w, S) * jax.nn.silu(zc)
    conv_state = u_ext[:, S:]
    nc = S // CHUNK
    qc = q.reshape(B, nc, CHUNK, N_HEADS, HEAD_DIM)
    pad = ((0, 0), (N_PAST_CHUNKS, 0), (0, 0), (0, 0), (0, 0))
    kp = jnp.pad(k.reshape(B, nc, CHUNK, N_HEADS, HEAD_DIM), pad)
    vp = jnp.pad(v.reshape(B, nc, CHUNK, N_HEADS, HEAD_DIM), pad)
    k_band = jnp.concatenate([kp[:, o:o + nc] for o in range(N_BAND)], axis=2)
    v_band = jnp.concatenate([vp[:, o:o + nc] for o in range(N_BAND)], axis=2)
    chunk_id = jnp.arange(nc)[:, None] - N_PAST_CHUNKS + jnp.arange(N_BAND)[None, :]
    valid = jnp.repeat(chunk_id >= 0, CHUNK, axis=1)[None, :, None, None, :]
    slot = jnp.arange(N_BAND * CHUNK)
    rel = (N_BAND - 1) * CHUNK + jnp.arange(CHUNK)[:, None] - slot[None, :]
    ya = band_attention(qc, k_band, v_band, rel, valid, rel_bias).reshape(B, S, D_ATT)
    ya = ya * jax.nn.silu(za)
    win = min(N_PAST_CHUNKS * CHUNK, S)
    k_state = k.reshape(B, S, N_HEADS, HEAD_DIM)[:, S - win:]
    v_state = v.reshape(B, S, N_HEADS, HEAD_DIM)[:, S - win:]
    x = x + merge_out(yc, ya, norm_conv, norm_att, w_out)
    x = per_layer_embed(x, p, ple_norm, w_ple_gate, w_ple_proj)
    return x, k_state, v_state, conv_state


def sample_layer(x, p, cache_k, cache_v, conv_buf, norm_in, w_in, conv_w, rel_bias, norm_conv,
                 norm_att, w_out, ple_norm, w_ple_gate, w_ple_proj):
    B, S, _ = x.shape
    xn = rmsnorm(x, norm_in)
    h, bg, cg, zc, q, k, v, za = project_in(xn, w_in)
    u = cg * h
    u_ext = jnp.concatenate([conv_buf.astype(u.dtype), u], axis=1)
    yc = bg * short_conv(u_ext, conv_w, S) * jax.nn.silu(zc)
    conv_state = u_ext[:, S:]
    qh = q.reshape(B, S, N_HEADS, HEAD_DIM)
    kh = k.reshape(B, S, N_HEADS, HEAD_DIM)
    vh = v.reshape(B, S, N_HEADS, HEAD_DIM)
    kv_win = cache_k.shape[1]
    k_all = jnp.concatenate([cache_k.astype(kh.dtype), kh], axis=1)
    v_all = jnp.concatenate([cache_v.astype(vh.dtype), vh], axis=1)
    kpos = jnp.concatenate([jnp.arange(kv_win) - kv_win, jnp.arange(S)])
    rel = jnp.arange(S)[:, None] - kpos[None, :]
    ya = band_attention(qh, k_all, v_all, rel, None, rel_bias).reshape(B, S, D_ATT)
    ya = ya * jax.nn.silu(za)
    x = x + merge_out(yc, ya, norm_conv, norm_att, w_out)
    x = per_layer_embed(x, p, ple_norm, w_ple_gate, w_ple_proj)
    return x, kh, vh, conv_state


def setup_inputs(seed: int = 0) -> dict:
    key = jax.random.key(seed)
    ks = jax.random.split(key, 20)
    kv_win = min(N_PAST_CHUNKS * CHUNK, PAST_LEN)
    f32 = jnp.float32
    nrm = lambda k, shape, s: jax.random.normal(k, shape, f32) * s
    return {
        "x_prompt": nrm(ks[0], (BATCH, SEQ, D_MODEL), 1.0),
        "x_sample": nrm(ks[1], (DEC_BATCH, DEC_SEQ, D_MODEL), 1.0),
        "cache_k": nrm(ks[2], (DEPTH, DEC_BATCH, kv_win, N_HEADS, HEAD_DIM), 1.0),
        "cache_v": nrm(ks[3], (DEPTH, DEC_BATCH, kv_win, N_HEADS, HEAD_DIM), 1.0),
        "state_conv": nrm(ks[4], (DEPTH, DEC_BATCH, CONV_W - 1, D_CONV), 1.0),
        "p_prompt": nrm(ks[5], (DEPTH, BATCH, SEQ, D_PLE), 1.0),
        "p_sample": nrm(ks[6], (DEPTH, DEC_BATCH, DEC_SEQ, D_PLE), 1.0),
        "norm_in": 1.0 + nrm(ks[7], (DEPTH, D_MODEL), 0.02),
        "w_in": nrm(ks[8], (DEPTH, D_MODEL, D_IN), D_MODEL ** -0.5),
        "conv_w": nrm(ks[9], (DEPTH, CONV_W, D_CONV), CONV_W ** -0.5),
        "rel_bias": nrm(ks[10], (DEPTH, N_HEADS, N_REL), 0.5),
        "norm_conv": 1.0 + nrm(ks[11], (DEPTH, D_CONV), 0.02),
        "norm_att": 1.0 + nrm(ks[12], (DEPTH, D_ATT), 0.02),
        "w_out": nrm(ks[13], (DEPTH, D_CONV + D_ATT, D_MODEL), (D_CONV + D_ATT) ** -0.5),
        "ple_norm": 1.0 + nrm(ks[14], (DEPTH, D_MODEL), 0.02),
        "w_ple_gate": nrm(ks[15], (DEPTH, D_MODEL, D_MODEL), D_MODEL ** -0.5),
        "w_ple_proj": nrm(ks[16], (DEPTH, D_PLE, D_MODEL), D_PLE ** -0.5),
        "final_norm": 1.0 + nrm(ks[17], (D_MODEL,), 0.02),
    }


def reference(x_prompt, x_sample, cache_k, cache_v, state_conv, p_prompt, p_sample, norm_in, w_in,
              conv_w, rel_bias, norm_conv, norm_att, w_out, ple_norm, w_ple_gate, w_ple_proj,
              final_norm):
    xp, xs = x_prompt, x_sample
    kp_l, vp_l, cp_l, ks_l, vs_l, cs_l = [], [], [], [], [], []
    for i in range(DEPTH):
        xp, kpi, vpi, cpi = prompt_layer(xp, p_prompt[i], norm_in[i], w_in[i], conv_w[i], rel_bias[i],
                                         norm_conv[i], norm_att[i], w_out[i], ple_norm[i],
                                         w_ple_gate[i], w_ple_proj[i])
        xs, ksi, vsi, csi = sample_layer(xs, p_sample[i], cache_k[i], cache_v[i], state_conv[i],
                                         norm_in[i], w_in[i], conv_w[i], rel_bias[i], norm_conv[i],
                                         norm_att[i], w_out[i], ple_norm[i], w_ple_gate[i],
                                         w_ple_proj[i])
        kp_l.append(kpi); vp_l.append(vpi); cp_l.append(cpi)
        ks_l.append(ksi); vs_l.append(vsi); cs_l.append(csi)
    y_prompt = rmsnorm(xp, final_norm)
    y_sample = rmsnorm(xs, final_norm)
    k_prompt = jnp.stack(kp_l)
    v_prompt = jnp.stack(vp_l)
    conv_prompt = jnp.stack(cp_l)
    k_sample = jnp.stack(ks_l)
    v_sample = jnp.stack(vs_l)
    conv_sample = jnp.stack(cs_l)
    return (y_prompt, y_sample, k_prompt, v_prompt, conv_prompt, k_sample, v_sample, conv_sample)
```

```cpp
#include <hip/hip_runtime.h>
#include <hip/hip_cooperative_groups.h>
#include <cstdio>
#include <cstdint>
namespace cg = cooperative_groups;
#ifndef N_LAUNCH_MODE
#define N_LAUNCH_MODE 1
#endif
namespace pg8 {
#define PG8_LAS __attribute__((address_space(3)))
typedef unsigned short bf16_t;
typedef short bf16x8 __attribute__((ext_vector_type(8)));
typedef float f32x4 __attribute__((ext_vector_type(4)));
typedef unsigned u32x4 __attribute__((ext_vector_type(4)));
constexpr int BM = 256, BK = 64, HALF = 128, HTB = HALF * BK * 2  , STAGE_BYTES = 8 * HTB, NXCD = 8, WGM = 8;

__host__ __device__ __forceinline__ int lds_byte(int r, int c) { const int st = (r >> 4) * 2 + (c >> 5), rr = r & 15, cc = c & 31, ob = rr * 64 + cc * 2; return st * 1024 + (ob ^ (((ob >> 9) & 1) << 5)); }
__host__ __device__ __forceinline__ void stage_rc(int b, int& R, int& C) { const int st = b / 1024, sb = b % 1024, swz = sb ^ (((sb >> 9) & 1) << 5); R = (st >> 1) * 16 + swz / 64; C = (st & 1) * 32 + (swz % 64) / 2; }
__host__ __device__ __forceinline__ int perm32(int rho) { const int n = rho >> 4, i = rho & 15; return 8 * (i >> 2) + 4 * n + (i & 3); }

struct Unit { int pm, pn; };
struct Gemm { const bf16_t* A; const bf16_t* Bt; int M, N, K; };

struct StaticOrder {
    int nM, nN, nwg, G, c;
    __host__ __device__ void init(int M, int N, int G_, int c_) { nM = M / BM; nN = N / BM; nwg = nM * nN; G = G_; c = c_; }
    __host__ __device__ bool next(int i, Unit& u) const {
        const long L = (long)i * G + c; if (L >= nwg) return false;
        int wgid = (int)L; { const int q = nwg / NXCD, r = nwg % NXCD, xcd = wgid % NXCD, off = wgid / NXCD; wgid = (xcd < r ? xcd * (q + 1) : r * (q + 1) + (xcd - r) * q) + off; }
        const int nig = WGM * nN, gid = wgid / nig, fm = gid * WGM, gsz = (nM - fm) < WGM ? (nM - fm) : WGM;
        u.pm = fm + ((wgid % nig) % gsz); u.pn = (wgid % nig) / gsz; return true;
    }
    __device__ __forceinline__ void a_ready(const Unit&) const {}
    __device__ __forceinline__ void done(const Unit&) const {}
};

__device__ __forceinline__ unsigned cvt_pk_bf16(float lo, float hi) { unsigned r; asm volatile("v_cvt_pk_bf16_f32 %0, %1, %2" : "=v"(r) : "v"(lo), "v"(hi)); return r; }
typedef float f32x2 __attribute__((ext_vector_type(2)));
constexpr long OFF_YS = 33554432L, OFF_KP = 34603008L, OFF_VP = 36700160L, OFF_CP = 38797312L, OFF_KS = 38805504L, OFF_VS = 39329792L, OFF_CS = 39854080L, OUT_TOTAL = 39886848L;
constexpr float RMS_EPS = 1e-6f;
struct EpiZ {
    static constexpr bool PERM = true, AFTER_DRAIN = false;
    bf16_t* Z; float* out;
    __device__ __forceinline__ void operator()(const f32x4 (&acc)[2][2][4][2], const Unit& u, int wr, int wc, int fr, int fq) const {
        const int row0 = u.pm * BM + wr * 64 + fr, col0 = u.pn * BM + wc * 32 + 8 * fq;
        const bool kv = (u.pn >= 10 && u.pn < 14), samp = u.pm >= 128, st = kv && (samp || (u.pm & 15) >= 14), isk = u.pn < 12;
        const int rowsub = samp ? 32768 : 3584 * (u.pm / 16 + 1), colsub = isk ? 2560 : 3072;
        float* sp = out + (samp ? (isk ? OFF_KS : OFF_VS) : (isk ? OFF_KP : OFF_VP));
#pragma unroll
        for (int ai = 0; ai < 2; ++ai)
#pragma unroll
            for (int m = 0; m < 4; ++m) { const int row = row0 + ai * HALF + m * 16; bf16_t* rowp = Z + (size_t)row * 4096 + col0;
#pragma unroll
                for (int bj = 0; bj < 2; ++bj) { const f32x4 v0 = acc[ai][bj][m][0], v1 = acc[ai][bj][m][1];
                    u32x4 w; w.x = cvt_pk_bf16(v0[0], v0[1]); w.y = cvt_pk_bf16(v0[2], v0[3]); w.z = cvt_pk_bf16(v1[0], v1[1]); w.w = cvt_pk_bf16(v1[2], v1[3]);
                    *(u32x4*)(rowp + bj * HALF) = w;
                    if (st) { float* d = sp + (size_t)(row - rowsub) * 512 + (col0 + bj * HALF - colsub); *(f32x4*)d = v0; *(f32x4*)(d + 4) = v1; } } }
    }
};
struct EpiPlain {
    static constexpr bool PERM = true, AFTER_DRAIN = false;
    bf16_t* O; int ldc;
    __device__ __forceinline__ void operator()(const f32x4 (&acc)[2][2][4][2], const Unit& u, int wr, int wc, int fr, int fq) const {
        const int row0 = u.pm * BM + wr * 64 + fr, col0 = u.pn * BM + wc * 32 + 8 * fq;
#pragma unroll
        for (int ai = 0; ai < 2; ++ai)
#pragma unroll
            for (int m = 0; m < 4; ++m) { bf16_t* rowp = O + (size_t)(row0 + ai * HALF + m * 16) * ldc + col0;
#pragma unroll
                for (int bj = 0; bj < 2; ++bj) { const f32x4 v0 = acc[ai][bj][m][0], v1 = acc[ai][bj][m][1];
                    u32x4 w; w.x = cvt_pk_bf16(v0[0], v0[1]); w.y = cvt_pk_bf16(v0[2], v0[3]); w.z = cvt_pk_bf16(v1[0], v1[1]); w.w = cvt_pk_bf16(v1[2], v1[3]);
                    *(u32x4*)(rowp + bj * HALF) = w; } }
    }
};
struct EpiX1 {
    static constexpr bool PERM = true, AFTER_DRAIN = false;
    const float* xp; const float* xs; float* outx; bf16_t* X1N; const float* g; float* SS;
    __device__ __forceinline__ void operator()(const f32x4 (&acc)[2][2][4][2], const Unit& u, int wr, int wc, int fr, int fq) const {
        const int row0 = u.pm * BM + wr * 64 + fr, col0 = u.pn * BM + wc * 32 + 8 * fq;
        f32x4 gv[2][2];
#pragma unroll
        for (int bj = 0; bj < 2; ++bj)
#pragma unroll
            for (int n = 0; n < 2; ++n) gv[bj][n] = *(const f32x4*)(g + col0 + bj * HALF + 4 * n);
#pragma unroll
        for (int ai = 0; ai < 2; ++ai)
#pragma unroll
            for (int m = 0; m < 4; ++m) { const int row = row0 + ai * HALF + m * 16;
                const float* xrow = (row < 32768 ? xp + (size_t)row * 1024 : xs + (size_t)(row - 32768) * 1024) + col0;
                float ss = 0.f;
#pragma unroll
                for (int bj = 0; bj < 2; ++bj) { const size_t off = (size_t)row * 1024 + col0 + bj * HALF;
                    const f32x4 v0 = acc[ai][bj][m][0] + *(const f32x4*)(xrow + bj * HALF), v1 = acc[ai][bj][m][1] + *(const f32x4*)(xrow + bj * HALF + 4);
                    *(f32x4*)(outx + off) = v0; *(f32x4*)(outx + off + 4) = v1;
                    ss += (v0[0] * v0[0] + v0[1] * v0[1]) + (v0[2] * v0[2] + v0[3] * v0[3]) + (v1[0] * v1[0] + v1[1] * v1[1]) + (v1[2] * v1[2] + v1[3] * v1[3]);
                    const f32x4 a = v0 * gv[bj][0], b = v1 * gv[bj][1];
                    u32x4 w; w.x = cvt_pk_bf16(a[0], a[1]); w.y = cvt_pk_bf16(a[2], a[3]); w.z = cvt_pk_bf16(b[0], b[1]); w.w = cvt_pk_bf16(b[2], b[3]);
                    *(u32x4*)(X1N + off) = w; }
                ss += __shfl_xor(ss, 16); ss += __shfl_xor(ss, 32);
                if (fq == 0) SS[(size_t)row * 16 + u.pn * 4 + wc] = ss; }
    }
};
__device__ __forceinline__ float bf_lo(unsigned w) { return __uint_as_float(w << 16); }
__device__ __forceinline__ float bf_hi(unsigned w) { return __uint_as_float(w & 0xffff0000u); }
struct EpiGate {
    static constexpr bool PERM = true, AFTER_DRAIN = false;
    float* outx; const bf16_t* PP; const float* SS1; float* SS2;
    __device__ __forceinline__ void operator()(const f32x4 (&acc)[2][2][4][2], const Unit& u, int wr, int wc, int fr, int fq) const {
        const int row0 = u.pm * BM + wr * 64 + fr, col0 = u.pn * BM + wc * 32 + 8 * fq;
#pragma unroll
        for (int ai = 0; ai < 2; ++ai)
#pragma unroll
            for (int m = 0; m < 4; ++m) { const int row = row0 + ai * HALF + m * 16;
                const f32x4* sp = (const f32x4*)(SS1 + (size_t)row * 16); const f32x4 s0 = sp[0], s1 = sp[1], s2 = sp[2], s3 = sp[3];
                const float tot = ((s0[0] + s0[1]) + (s0[2] + s0[3])) + ((s1[0] + s1[1]) + (s1[2] + s1[3])) + ((s2[0] + s2[1]) + (s2[2] + s2[3])) + ((s3[0] + s3[1]) + (s3[2] + s3[3]));
                const float r1 = -1.4426950408889634f / sqrtf(tot * (1.0f / 1024.0f) + RMS_EPS);
                float ss = 0.f;
#pragma unroll
                for (int bj = 0; bj < 2; ++bj) { const size_t off = (size_t)row * 1024 + col0 + bj * HALF;
                    const f32x4 x0 = *(const f32x4*)(outx + off), x1 = *(const f32x4*)(outx + off + 4); const u32x4 pw = *(const u32x4*)(PP + off);
                    const f32x4 a0 = acc[ai][bj][m][0] * r1, a1 = acc[ai][bj][m][1] * r1;
                    f32x4 g0, g1;
#pragma unroll
                    for (int e = 0; e < 4; ++e) { g0[e] = __builtin_amdgcn_rcpf(1.0f + __builtin_amdgcn_exp2f(a0[e])); g1[e] = __builtin_amdgcn_rcpf(1.0f + __builtin_amdgcn_exp2f(a1[e])); }
                    const f32x4 p0 = {bf_lo(pw.x), bf_hi(pw.x), bf_lo(pw.y), bf_hi(pw.y)}, p1 = {bf_lo(pw.z), bf_hi(pw.z), bf_lo(pw.w), bf_hi(pw.w)};
                    const f32x4 v0 = x0 + g0 * p0, v1 = x1 + g1 * p1;
                    *(f32x4*)(outx + off) = v0; *(f32x4*)(outx + off + 4) = v1;
                    ss += (v0[0] * v0[0] + v0[1] * v0[1]) + (v0[2] * v0[2] + v0[3] * v0[3]) + (v1[0] * v1[0] + v1[1] * v1[1]) + (v1[2] * v1[2] + v1[3] * v1[3]); }
                ss += __shfl_xor(ss, 16); ss += __shfl_xor(ss, 32);
                if (fq == 0) SS2[(size_t)row * 16 + u.pn * 4 + wc] = ss; }
    }
};

template <class Epi, class Sched, bool ALIGN_EPI = false, bool SP2 = false>
__device__ __forceinline__ void gemm_phase(PG8_LAS unsigned char* lds, const Gemm g, const Sched& S, const Epi& E) {
    int tid_ = threadIdx.x; asm volatile("" : "+v"(tid_));
    const int tid = tid_, wid = __builtin_amdgcn_readfirstlane(tid >> 6), lane = tid & 63, wr = wid >> 2, wc = wid & 3, fr = lane & 15, fq = lane >> 4;
    const int K = g.K, nt = K / BK;
    unsigned voffA[2], voffB[2];
#pragma unroll
    for (int i = 0; i < 2; ++i) { int R, C; stage_rc(tid * 16 + i * 8192, R, C); const int Rb = Epi::PERM ? ((R & ~31) + perm32(R & 31)) : R;
        voffA[i] = (unsigned)(R * K + C) * 2u; voffB[i] = (unsigned)(Rb * K + C) * 2u; }
    const size_t kstep = (size_t)(BK * 2);
    const size_t hstep = (size_t)HALF * K * 2;
    const size_t tstep = 2 * hstep;
    const unsigned ldsw = (unsigned)wid * 1024u;
    const int aoff = lds_byte(wr * 64 + fr, fq * 8), boff = lds_byte(wc * 32 + fr, fq * 8);
#define PG8_SA(b, h) (((b) * 2 + (h)) * HTB)
#define PG8_SB(b, h) ((4 + (b) * 2 + (h)) * HTB)
#define PG8_STAGE(bufoff, gbase, voff) do { _Pragma("unroll") for (int _i = 0; _i < 2; ++_i) \
        __builtin_amdgcn_global_load_lds((const unsigned*)((const char*)(gbase) + (voff)[_i]), (PG8_LAS unsigned*)(lds + (bufoff) + ldsw + _i * 8192), 16, 0, 0); } while (0)
#define PG8_LDA(dst, b, h) do { _Pragma("unroll") for (int m = 0; m < 4; ++m) _Pragma("unroll") for (int k = 0; k < 2; ++k) dst[m][k] = *(const PG8_LAS bf16x8*)(lds + PG8_SA(b, h) + aoff + m * 2048 + k * 1024); } while (0)
#define PG8_LDB(dst, b, h) do { _Pragma("unroll") for (int n = 0; n < 2; ++n) _Pragma("unroll") for (int k = 0; k < 2; ++k) dst[n][k] = *(const PG8_LAS bf16x8*)(lds + PG8_SB(b, h) + boff + n * 2048 + k * 1024); } while (0)
#define PG8_MMA(ai, bj, At, Bt) do { __builtin_amdgcn_s_setprio(1); _Pragma("unroll") for (int m = 0; m < 4; ++m) _Pragma("unroll") for (int n = 0; n < 2; ++n) _Pragma("unroll") for (int k = 0; k < 2; ++k) \
        acc[ai][bj][m][n] = __builtin_amdgcn_mfma_f32_16x16x32_bf16(Bt[n][k], At[m][k], acc[ai][bj][m][n], 0, 0, 0); __builtin_amdgcn_s_setprio(0); } while (0)
#define PG8_WAIT_V(n) asm volatile("s_waitcnt vmcnt(" #n ")" ::: "memory")
#define PG8_WAIT_L(n) asm volatile("s_waitcnt lgkmcnt(" #n ")" ::: "memory")
#define PG8_BAR __builtin_amdgcn_s_barrier()
#define PG8_SCHED __builtin_amdgcn_sched_barrier(0)
    Unit cur, nxt; int ui = 0;
    if (!S.next(0, cur)) return;
    f32x4 acc[2][2][4][2];
#pragma unroll
    for (int a = 0; a < 2; ++a)
#pragma unroll
        for (int b = 0; b < 2; ++b)
#pragma unroll
            for (int m = 0; m < 4; ++m)
#pragma unroll
                for (int n = 0; n < 2; ++n) acc[a][b][m][n] = (f32x4){0.f, 0.f, 0.f, 0.f};
    bf16x8 At[4][2], B0[2][2], B1[2][2];
    const char* cA = (const char*)g.A + (size_t)cur.pm * tstep; const char* cB = (const char*)g.Bt + (size_t)cur.pn * tstep;
    S.a_ready(cur);
    if constexpr (SP2) {
        PG8_STAGE(PG8_SB(0, 0), cB, voffB); PG8_STAGE(PG8_SB(0, 1), cB + hstep, voffB); PG8_STAGE(PG8_SA(0, 0), cA, voffA); PG8_STAGE(PG8_SA(0, 1), cA + hstep, voffA);
        if (wr == 1) PG8_BAR;
        PG8_WAIT_V(2); PG8_BAR;
        PG8_STAGE(PG8_SB(1, 0), cB + kstep, voffB); PG8_STAGE(PG8_SA(1, 0), cA + kstep, voffA); PG8_STAGE(PG8_SB(1, 1), cB + hstep + kstep, voffB);
        PG8_WAIT_V(6); PG8_BAR;
    } else {
        PG8_STAGE(PG8_SB(0, 0), cB, voffB); PG8_STAGE(PG8_SA(0, 0), cA, voffA); PG8_STAGE(PG8_SB(0, 1), cB + hstep, voffB); PG8_STAGE(PG8_SA(0, 1), cA + hstep, voffA);
        if (wr == 1) PG8_BAR;
        PG8_WAIT_V(4); PG8_BAR;
        PG8_STAGE(PG8_SB(1, 0), cB + kstep, voffB); PG8_STAGE(PG8_SA(1, 0), cA + kstep, voffA); PG8_STAGE(PG8_SB(1, 1), cB + hstep + kstep, voffB);
        PG8_WAIT_V(6); PG8_BAR;
    }
    for (;;) {
        const bool has_next = S.next(ui + 1, nxt);
        const char* nA = has_next ? (const char*)g.A + (size_t)nxt.pm * tstep : cA; const char* nB = has_next ? (const char*)g.Bt + (size_t)nxt.pn * tstep : cB;
        for (int t = 0; t < nt; t += 2) {
            const bool last = (t == nt - 2);
            const char* a1 = cA + (size_t)(t + 1) * kstep;
            const char* a2 = last ? nA : cA + (size_t)(t + 2) * kstep; const char* b2 = last ? nB : cB + (size_t)(t + 2) * kstep;
            const char* a3 = a2 + kstep; const char* b3 = b2 + kstep;
            if (last && has_next) S.a_ready(nxt);
            if constexpr (SP2) {
            PG8_LDB(B0, 0, 0); PG8_LDB(B1, 0, 1); PG8_SCHED; PG8_LDA(At, 0, 0); PG8_STAGE(PG8_SA(1, 1), a1 + hstep, voffA);
            PG8_WAIT_V(8); PG8_WAIT_L(0); PG8_BAR; PG8_MMA(0, 0, At, B0); PG8_MMA(0, 1, At, B1); PG8_BAR; PG8_SCHED;
            PG8_LDA(At, 0, 1); PG8_STAGE(PG8_SB(0, 0), b2, voffB); PG8_STAGE(PG8_SB(0, 1), b2 + hstep, voffB); PG8_STAGE(PG8_SA(0, 0), a2, voffA);
            PG8_WAIT_V(8); PG8_WAIT_L(0); PG8_BAR; PG8_MMA(1, 0, At, B0); PG8_MMA(1, 1, At, B1); PG8_BAR; PG8_SCHED;
            PG8_LDB(B0, 1, 0); PG8_LDB(B1, 1, 1); PG8_SCHED; PG8_LDA(At, 1, 0); PG8_STAGE(PG8_SA(0, 1), a2 + hstep, voffA);
            PG8_WAIT_V(8); PG8_WAIT_L(0); PG8_BAR; PG8_MMA(0, 0, At, B0); PG8_MMA(0, 1, At, B1); PG8_BAR; PG8_SCHED;
            PG8_LDA(At, 1, 1); PG8_STAGE(PG8_SB(1, 0), b3, voffB); PG8_STAGE(PG8_SB(1, 1), b3 + hstep, voffB); PG8_STAGE(PG8_SA(1, 0), a3, voffA);
            PG8_WAIT_V(8); PG8_WAIT_L(0); PG8_BAR; PG8_MMA(1, 0, At, B0); PG8_MMA(1, 1, At, B1); PG8_BAR; PG8_SCHED;
            } else {
            PG8_LDB(B0, 0, 0); PG8_SCHED; PG8_LDA(At, 0, 0); PG8_STAGE(PG8_SA(1, 1), a1 + hstep, voffA);
            PG8_WAIT_L(8); PG8_BAR; PG8_WAIT_L(0); PG8_MMA(0, 0, At, B0); PG8_BAR; PG8_SCHED;
            PG8_LDB(B1, 0, 1); PG8_STAGE(PG8_SB(0, 0), b2, voffB);
            PG8_BAR; PG8_WAIT_L(0); PG8_MMA(0, 1, At, B1); PG8_BAR;
            PG8_LDA(At, 0, 1); PG8_STAGE(PG8_SA(0, 0), a2, voffA);
            PG8_BAR; PG8_WAIT_L(0); PG8_MMA(1, 0, At, B0); PG8_BAR; PG8_SCHED;
            PG8_STAGE(PG8_SB(0, 1), b2 + hstep, voffB);
            PG8_WAIT_V(6); PG8_BAR; PG8_MMA(1, 1, At, B1); PG8_BAR;
            PG8_LDB(B0, 1, 0); PG8_SCHED; PG8_LDA(At, 1, 0); PG8_STAGE(PG8_SA(0, 1), a2 + hstep, voffA);
            PG8_WAIT_L(8); PG8_BAR; PG8_WAIT_L(0); PG8_MMA(0, 0, At, B0); PG8_BAR; PG8_SCHED;
            PG8_LDB(B1, 1, 1); PG8_STAGE(PG8_SB(1, 0), b3, voffB);
            PG8_BAR; PG8_WAIT_L(0); PG8_MMA(0, 1, At, B1); PG8_BAR;
            PG8_LDA(At, 1, 1); PG8_STAGE(PG8_SA(1, 0), a3, voffA);
            PG8_BAR; PG8_WAIT_L(0); PG8_MMA(1, 0, At, B0); PG8_BAR; PG8_SCHED;
            PG8_STAGE(PG8_SB(1, 1), b3 + hstep, voffB);
            PG8_WAIT_V(6); PG8_BAR; PG8_MMA(1, 1, At, B1); PG8_BAR;
            }
        }
        if constexpr (ALIGN_EPI) { if (wr == 0) PG8_BAR; }
        if constexpr (!Epi::AFTER_DRAIN) { E(acc, cur, wr, wc, fr, fq); S.done(cur); }
        if (!has_next) break;
#pragma unroll
        for (int a = 0; a < 2; ++a)
#pragma unroll
            for (int b = 0; b < 2; ++b)
#pragma unroll
                for (int m = 0; m < 4; ++m)
#pragma unroll
                    for (int n = 0; n < 2; ++n) acc[a][b][m][n] = (f32x4){0.f, 0.f, 0.f, 0.f};
        cur = nxt; cA = nA; cB = nB; ++ui;
        if constexpr (ALIGN_EPI) { if (wr == 1) PG8_BAR; }
    }
    PG8_WAIT_V(0);
    if constexpr (!ALIGN_EPI) { if (wr == 0) PG8_BAR; }
    PG8_BAR;
    if constexpr (Epi::AFTER_DRAIN) { E.fused(acc, cur, wr, wc, fr, fq, lds, wid, lane); S.done(cur); }
#undef PG8_SA
#undef PG8_SB
#undef PG8_STAGE
#undef PG8_LDA
#undef PG8_LDB
#undef PG8_MMA
#undef PG8_WAIT_V
#undef PG8_WAIT_L
#undef PG8_BAR
#undef PG8_SCHED
}
}
#define LAS __attribute__((address_space(3)))
typedef unsigned short bf16;
typedef unsigned v4u __attribute__((ext_vector_type(4)));
typedef unsigned v2u __attribute__((ext_vector_type(2)));
typedef float f32x4 __attribute__((ext_vector_type(4)));
typedef float f32x16 __attribute__((ext_vector_type(16)));
typedef short bf16x8 __attribute__((ext_vector_type(8)));
typedef short s16x4 __attribute__((ext_vector_type(4)));
typedef short v4i16_t __attribute__((ext_vector_type(4)));
typedef float f32x2_t __attribute__((ext_vector_type(2)));
typedef __bf16 bf16x2_t __attribute__((ext_vector_type(2)));
#define LDS_WAIT() asm volatile("s_waitcnt lgkmcnt(0)" ::: "memory")
__device__ __forceinline__ unsigned pk2(float lo, float hi) { f32x2_t v = {lo, hi}; bf16x2_t b = __builtin_convertvector(v, bf16x2_t); return __builtin_bit_cast(unsigned, b); }
__device__ __forceinline__ float blo(unsigned w) { return __uint_as_float(w << 16); }
__device__ __forceinline__ float bhi(unsigned w) { return __uint_as_float(w & 0xffff0000u); }
__device__ __forceinline__ float wave_sum(float v) {
#pragma unroll
    for (int o = 1; o < 64; o <<= 1) v += __shfl_xor(v, o);
    return v;
}
__device__ __forceinline__ float silu_f(float x) { return x * __builtin_amdgcn_rcpf(1.0f + __builtin_amdgcn_exp2f(-1.4426950408889634f * x)); }

constexpr int NWAVES = 8;
constexpr int DM = 1024, TP = 32768, TS = 1024, TT = TP + TS, DIN = 4096, DPLE = 256, SEQ = 4096, NB = 8, DB = 32, DSEQ = 32, KVW = 512;
constexpr size_t MiB = 1u << 20;
constexpr size_t WS_WIN = 1 * MiB, WS_WOUT = 9 * MiB, WS_WG = 11 * MiB, WS_WP = 13 * MiB, WS_SS1 = 14 * MiB, WS_SS2 = 17 * MiB, WS_PB = 20 * MiB, WS_KC = 37 * MiB, WS_VC = 53 * MiB,
                 WS_XN = 70 * MiB  , WS_Z = 136 * MiB, WS_X1N = 136 * MiB  , WS_PP = 202 * MiB, WS_END = 400 * MiB;
constexpr int LDS_BYTES = 147456, RING_BYTES = 131072;

struct Args { const float* in[18]; float* out; unsigned char* ws; int ph_lo, ph_hi; };

__device__ __forceinline__ void p0_transpose_item(const float* W, int K, int N, bf16* WT, LAS float* scr, int item, int lane) {
    const int nblk = N / 32, kb = item / nblk, nb = item % nblk, k0 = 64 * kb, n0 = 32 * nb;
#pragma unroll 8
    for (int i = 0; i < 32; ++i) { const int kk = 2 * i + (lane >> 5); scr[kk * 33 + (lane & 31)] = W[(size_t)(k0 + kk) * N + n0 + (lane & 31)]; }
    LDS_WAIT(); asm volatile("" ::: "memory");
    const int c = lane & 7;
#pragma unroll
    for (int j = 0; j < 4; ++j) { const int n = (lane >> 3) + 8 * j; const LAS float* s = scr + (8 * c) * 33 + n;
        v4u o; o.x = pk2(s[0 * 33], s[1 * 33]); o.y = pk2(s[2 * 33], s[3 * 33]); o.z = pk2(s[4 * 33], s[5 * 33]); o.w = pk2(s[6 * 33], s[7 * 33]);
        *(v4u*)(WT + (size_t)(n0 + n) * K + k0 + 8 * c) = o; }
    LDS_WAIT(); asm volatile("" ::: "memory");
}
__device__ __forceinline__ void rms_row_to_bf16(const float* xrow, const float* g, bf16* orow, int lane) {
    const f32x4* xr = (const f32x4*)xrow + lane; const f32x4* gr = (const f32x4*)g + lane;
    f32x4 v[4]; float s = 0.f;
#pragma unroll
    for (int j = 0; j < 4; ++j) { v[j] = xr[64 * j]; s += (v[j].x * v[j].x + v[j].y * v[j].y) + (v[j].z * v[j].z + v[j].w * v[j].w); }
    const float rstd = 1.f / sqrtf(wave_sum(s) * (1.f / DM) + 1e-6f);
    v2u* o8 = (v2u*)orow + lane;
#pragma unroll
    for (int j = 0; j < 4; ++j) { const f32x4 gg = gr[64 * j]; v2u w; w.x = pk2(v[j].x * rstd * gg.x, v[j].y * rstd * gg.y); w.y = pk2(v[j].z * rstd * gg.z, v[j].w * rstd * gg.w); o8[64 * j] = w; }
}
__device__ __forceinline__ void cvt_stream(const float* src, bf16* dst, size_t n, size_t gtid, size_t gthreads) {
    for (size_t i = gtid * 8; i < n; i += gthreads * 8) { const f32x4 a = *(const f32x4*)(src + i), b = *(const f32x4*)(src + i + 4);
        v4u w; w.x = pk2(a.x, a.y); w.y = pk2(a.z, a.w); w.z = pk2(b.x, b.y); w.w = pk2(b.z, b.w); *(v4u*)(dst + i) = w; }
}

constexpr int VPITCH = 144;
constexpr int P2_WAVE_BYTES = 8192, P2_BIAS_OFF = 32 * VPITCH  , P2_SSA_OFF = 65536, P2_SSC_OFF = 65536 + 2048;
#define MFMA32(a, b, c) __builtin_amdgcn_mfma_f32_32x32x16_bf16((a), (b), (c), 0, 0, 0)
__device__ __forceinline__ s16x4 vtr(const LAS unsigned char* p) { return __builtin_bit_cast(s16x4, __builtin_amdgcn_ds_read_tr16_b64_v4i16((LAS v4i16_t*)p)); }

struct P2Unit {
    const bf16* zq;
    const bf16* kpast;
    const bf16* vpast;
    int past_pitch;
    int kb0;
    int ntok;
    int hist;
    const float* sconv;
    float* cstate;
    bf16* yn;
};

template <int NQB>
__device__ __forceinline__ void attn_wave(const P2Unit& U, int h, int lane, LAS unsigned char* vbuf, const LAS float* bias2, f32x16 (&o)[NQB][2], float (&linv)[NQB]) {
    const int r = lane & 31, hh = lane >> 5;
    bf16x8 qf[NQB][4];
#pragma unroll
    for (int qb = 0; qb < NQB; ++qb)
#pragma unroll
        for (int ks = 0; ks < 4; ++ks) qf[qb][ks] = *(const bf16x8*)(U.zq + (size_t)(32 * qb + r) * DIN + 2048 + h * 64 + 32 * hh + 8 * ks);
    float m[NQB], l[NQB];
#pragma unroll
    for (int qb = 0; qb < NQB; ++qb) { m[qb] = -1e30f; l[qb] = 0.f;
#pragma unroll
        for (int dh = 0; dh < 2; ++dh)
#pragma unroll
            for (int i = 0; i < 16; ++i) o[qb][dh][i] = 0.f; }
    const float bconst = bias2[256];
    const float C = 0.125f * 1.4426950408889634f;
    const int i16 = lane & 15, tq = i16 >> 2, tp = i16 & 3, blk = (lane >> 4) & 1;
    const LAS unsigned char* trb = vbuf + (4 * hh + tq) * VPITCH + 8 * (4 * blk + tp);
    for (int kb = U.kb0; kb < 16 + NQB; ++kb) {
        const bool past = kb < 16;
        const int pitch = past ? U.past_pitch : DIN;
        const bf16* kp = (past ? U.kpast + (size_t)(32 * kb) * U.past_pitch : U.zq + (size_t)(32 * (kb - 16)) * DIN + 2560) + h * 64;
        const bf16* vp = (past ? U.vpast + (size_t)(32 * kb) * U.past_pitch : U.zq + (size_t)(32 * (kb - 16)) * DIN + 3072) + h * 64;
        const int kbase = past ? -512 + 32 * kb : 32 * (kb - 16);
        bf16x8 kf[4]; v4u vv[4];
#pragma unroll
        for (int ks = 0; ks < 4; ++ks) kf[ks] = *(const bf16x8*)(kp + (size_t)r * pitch + 32 * hh + 8 * ks);
#pragma unroll
        for (int i = 0; i < 4; ++i) vv[i] = *(const v4u*)(vp + (size_t)(lane >> 1) * pitch + 32 * (lane & 1) + 8 * i);
        asm volatile("" ::: "memory");
#pragma unroll
        for (int i = 0; i < 4; ++i) *(LAS v4u*)(vbuf + (lane >> 1) * VPITCH + 64 * (lane & 1) + 16 * i) = vv[i];
        f32x16 s[NQB];
#pragma unroll
        for (int qb = 0; qb < NQB; ++qb) {
#pragma unroll
            for (int i = 0; i < 16; ++i) s[qb][i] = 0.f;
#pragma unroll
            for (int ks = 0; ks < 4; ++ks) s[qb] = MFMA32(kf[ks], qf[qb][ks], s[qb]);
        }
        bf16x8 pf[NQB][2];
        const bool lookup = kb >= 12;
#pragma unroll
        for (int qb = 0; qb < NQB; ++qb) {
            if (lookup) { const int relbase = (32 * qb + r) - kbase - 4 * hh + 128;
#pragma unroll
                for (int i = 0; i < 16; ++i) { int idx = relbase - ((i & 3) + 8 * (i >> 2)); idx = idx < 0 ? 0 : (idx > 256 ? 256 : idx); s[qb][i] = s[qb][i] * C + bias2[idx]; }
            } else {
#pragma unroll
                for (int i = 0; i < 16; ++i) s[qb][i] = s[qb][i] * C + bconst;
            }
            float mx = s[qb][0];
#pragma unroll
            for (int i = 1; i < 16; ++i) mx = fmaxf(mx, s[qb][i]);
            mx = fmaxf(mx, __shfl_xor(mx, 32));
            const float mn = fmaxf(m[qb], mx), alpha = __builtin_amdgcn_exp2f(m[qb] - mn); m[qb] = mn;
            float sum = 0.f;
#pragma unroll
            for (int i = 0; i < 16; ++i) { s[qb][i] = __builtin_amdgcn_exp2f(s[qb][i] - mn); sum += s[qb][i]; }
            l[qb] = l[qb] * alpha + sum;
#pragma unroll
            for (int dh = 0; dh < 2; ++dh)
#pragma unroll
                for (int i = 0; i < 16; ++i) o[qb][dh][i] *= alpha;
#pragma unroll
            for (int st = 0; st < 2; ++st) { v4u w; w.x = pk2(s[qb][8 * st + 0], s[qb][8 * st + 1]); w.y = pk2(s[qb][8 * st + 2], s[qb][8 * st + 3]); w.z = pk2(s[qb][8 * st + 4], s[qb][8 * st + 5]); w.w = pk2(s[qb][8 * st + 6], s[qb][8 * st + 7]);
                pf[qb][st] = __builtin_bit_cast(bf16x8, w); }
        }
        asm volatile("" ::: "memory");
#pragma unroll
        for (int st = 0; st < 2; ++st)
#pragma unroll
            for (int dh = 0; dh < 2; ++dh) {
                const s16x4 lo = vtr(trb + (16 * st) * VPITCH + 64 * dh), hi = vtr(trb + (16 * st + 8) * VPITCH + 64 * dh);
                const bf16x8 vt = __builtin_shufflevector(lo, hi, 0, 1, 2, 3, 4, 5, 6, 7);
#pragma unroll
                for (int qb = 0; qb < NQB; ++qb) o[qb][dh] = MFMA32(vt, pf[qb][st], o[qb][dh]);
            }
        asm volatile("" ::: "memory");
    }
#pragma unroll
    for (int qb = 0; qb < NQB; ++qb) { const float lt = l[qb] + __shfl_xor(l[qb], 32); linv[qb] = 1.0f / lt; }
}

template <int NQB>
__device__ __forceinline__ void p2_unit(const P2Unit& U, LAS unsigned char* lds, int wave, int lane, const float* conv_w, const float* norm_conv, const float* norm_att) {
    LAS unsigned char* wl = lds + wave * P2_WAVE_BYTES;
    LAS float* ssA = (LAS float*)(lds + P2_SSA_OFF); LAS float* ssC = (LAS float*)(lds + P2_SSC_OFF);
    const int r = lane & 31, hh = lane >> 5, h = wave;
    f32x16 o[NQB][2]; float linv[NQB];
    attn_wave<NQB>(U, h, lane, wl, (const LAS float*)(wl + P2_BIAS_OFF), o, linv);
#pragma unroll
    for (int qb = 0; qb < NQB; ++qb) {
        const bf16* za = U.zq + (size_t)(32 * qb + r) * DIN + 3584 + h * 64 + 4 * hh;
        float ss = 0.f;
#pragma unroll
        for (int dh = 0; dh < 2; ++dh)
#pragma unroll
            for (int g = 0; g < 4; ++g) { const v2u zw = *(const v2u*)(za + 32 * dh + 8 * g);
                const float z0 = blo(zw.x), z1 = bhi(zw.x), z2 = blo(zw.y), z3 = bhi(zw.y);
                float a0 = o[qb][dh][4 * g + 0] * linv[qb] * silu_f(z0), a1 = o[qb][dh][4 * g + 1] * linv[qb] * silu_f(z1), a2 = o[qb][dh][4 * g + 2] * linv[qb] * silu_f(z2), a3 = o[qb][dh][4 * g + 3] * linv[qb] * silu_f(z3);
                o[qb][dh][4 * g + 0] = a0; o[qb][dh][4 * g + 1] = a1; o[qb][dh][4 * g + 2] = a2; o[qb][dh][4 * g + 3] = a3;
                ss += (a0 * a0 + a1 * a1) + (a2 * a2 + a3 * a3); }
        ss += __shfl_xor(ss, 32);
        if (hh == 0) ssA[(32 * qb + r) * 8 + h] = ss;
    }
    __syncthreads();
#pragma unroll
    for (int qb = 0; qb < NQB; ++qb) {
        const LAS f32x4* sp = (const LAS f32x4*)(ssA + (32 * qb + r) * 8); const f32x4 a = sp[0], b = sp[1];
        const float ra = 1.0f / sqrtf((((a.x + a.y) + (a.z + a.w)) + ((b.x + b.y) + (b.z + b.w))) * (1.0f / 512.0f) + 1e-6f);
        bf16* yr = U.yn + (size_t)(32 * qb + r) * DM + 512 + h * 64 + 4 * hh;
        const float* ga = norm_att + h * 64 + 4 * hh;
#pragma unroll
        for (int dh = 0; dh < 2; ++dh)
#pragma unroll
            for (int g = 0; g < 4; ++g) { const f32x4 gg = *(const f32x4*)(ga + 32 * dh + 8 * g);
                v2u w; w.x = pk2(o[qb][dh][4 * g + 0] * ra * gg.x, o[qb][dh][4 * g + 1] * ra * gg.y); w.y = pk2(o[qb][dh][4 * g + 2] * ra * gg.z, o[qb][dh][4 * g + 3] * ra * gg.w);
                *(v2u*)(yr + 32 * dh + 8 * g) = w; }
    }
    const int c0 = 64 * wave + 8 * (lane & 7), tg = lane >> 3;
    const bool active = 8 * tg < U.ntok;
    float yc[8][8];
    {
        float w0[8], w1[8], w2[8];
#pragma unroll
        for (int e = 0; e < 8; ++e) { w0[e] = conv_w[c0 + e]; w1[e] = conv_w[512 + c0 + e]; w2[e] = conv_w[1024 + c0 + e]; }
        float u2[8], u1[8];
#pragma unroll
        for (int e = 0; e < 8; ++e) { u2[e] = 0.f; u1[e] = 0.f; }
        if (active) {
            if (tg > 0 || U.hist == 1) {
                const bf16* zr = U.zq + ((long)(8 * tg) - 2) * DIN + c0;
                const v4u h2 = *(const v4u*)(zr), g2 = *(const v4u*)(zr + 1024), h1 = *(const v4u*)(zr + DIN), g1 = *(const v4u*)(zr + DIN + 1024);
                u2[0] = blo(h2.x) * blo(g2.x); u2[1] = bhi(h2.x) * bhi(g2.x); u2[2] = blo(h2.y) * blo(g2.y); u2[3] = bhi(h2.y) * bhi(g2.y);
                u2[4] = blo(h2.z) * blo(g2.z); u2[5] = bhi(h2.z) * bhi(g2.z); u2[6] = blo(h2.w) * blo(g2.w); u2[7] = bhi(h2.w) * bhi(g2.w);
                u1[0] = blo(h1.x) * blo(g1.x); u1[1] = bhi(h1.x) * bhi(g1.x); u1[2] = blo(h1.y) * blo(g1.y); u1[3] = bhi(h1.y) * bhi(g1.y);
                u1[4] = blo(h1.z) * blo(g1.z); u1[5] = bhi(h1.z) * bhi(g1.z); u1[6] = blo(h1.w) * blo(g1.w); u1[7] = bhi(h1.w) * bhi(g1.w);
            } else if (U.hist == 2) {
#pragma unroll
                for (int e = 0; e < 8; ++e) { u2[e] = U.sconv[c0 + e]; u1[e] = U.sconv[512 + c0 + e]; }
            }
        }
#pragma unroll
        for (int j = 0; j < 8; ++j) {
            float u0[8];
            if (active) {
                const bf16* zr = U.zq + (size_t)(8 * tg + j) * DIN + c0;
                const v4u hv = *(const v4u*)(zr), bv = *(const v4u*)(zr + 512), gv = *(const v4u*)(zr + 1024), zv = *(const v4u*)(zr + 1536);
                u0[0] = blo(hv.x) * blo(gv.x); u0[1] = bhi(hv.x) * bhi(gv.x); u0[2] = blo(hv.y) * blo(gv.y); u0[3] = bhi(hv.y) * bhi(gv.y);
                u0[4] = blo(hv.z) * blo(gv.z); u0[5] = bhi(hv.z) * bhi(gv.z); u0[6] = blo(hv.w) * blo(gv.w); u0[7] = bhi(hv.w) * bhi(gv.w);
                const float bb[8] = {blo(bv.x), bhi(bv.x), blo(bv.y), bhi(bv.y), blo(bv.z), bhi(bv.z), blo(bv.w), bhi(bv.w)};
                const float zz[8] = {blo(zv.x), bhi(zv.x), blo(zv.y), bhi(zv.y), blo(zv.z), bhi(zv.z), blo(zv.w), bhi(zv.w)};
                float ss = 0.f;
#pragma unroll
                for (int e = 0; e < 8; ++e) { const float cv = w0[e] * u2[e] + w1[e] * u1[e] + w2[e] * u0[e]; const float y = bb[e] * cv * silu_f(zz[e]); yc[j][e] = y; ss += y * y; }
                ss += __shfl_xor(ss, 1); ss += __shfl_xor(ss, 2); ss += __shfl_xor(ss, 4);
                if ((lane & 7) == 0) ssC[(8 * tg + j) * 8 + wave] = ss;
                if (U.cstate && j >= 6 && 8 * tg + 8 == U.ntok) { float* d = U.cstate + (j - 6) * 512 + c0; *(f32x4*)d = (f32x4){u0[0], u0[1], u0[2], u0[3]}; *(f32x4*)(d + 4) = (f32x4){u0[4], u0[5], u0[6], u0[7]}; }
            } else {
#pragma unroll
                for (int e = 0; e < 8; ++e) { u0[e] = 0.f; yc[j][e] = 0.f; }
            }
#pragma unroll
            for (int e = 0; e < 8; ++e) { u2[e] = u1[e]; u1[e] = u0[e]; }
        }
    }
    __syncthreads();
    if (active) {
        const f32x4 g0 = *(const f32x4*)(norm_conv + c0), g1 = *(const f32x4*)(norm_conv + c0 + 4);
#pragma unroll
        for (int j = 0; j < 8; ++j) {
            const LAS f32x4* sp = (const LAS f32x4*)(ssC + (8 * tg + j) * 8); const f32x4 a = sp[0], b = sp[1];
            const float rc = 1.0f / sqrtf((((a.x + a.y) + (a.z + a.w)) + ((b.x + b.y) + (b.z + b.w))) * (1.0f / 512.0f) + 1e-6f);
            v4u w; w.x = pk2(yc[j][0] * rc * g0.x, yc[j][1] * rc * g0.y); w.y = pk2(yc[j][2] * rc * g0.z, yc[j][3] * rc * g0.w);
            w.z = pk2(yc[j][4] * rc * g1.x, yc[j][5] * rc * g1.y); w.w = pk2(yc[j][6] * rc * g1.z, yc[j][7] * rc * g1.w);
            *(v4u*)(U.yn + (size_t)(8 * tg + j) * DM + c0) = w;
        }
    }
}
__global__ void __launch_bounds__(NWAVES * 64) fwd_kernel(Args args) {
    extern __shared__ __attribute__((aligned(16))) unsigned char lds_raw[];
    LAS unsigned char* lds = (LAS unsigned char*)lds_raw;
    cg::grid_group grid = cg::this_grid();
    const int G = gridDim.x, bx = blockIdx.x;
    const int vcu = (G % 8 == 0) ? (bx % 8) * (G / 8) + bx / 8 : bx;
    unsigned char* ws = args.ws; float* out = args.out;
    const float *x_prompt = args.in[0], *x_sample = args.in[1], *cache_k = args.in[2], *cache_v = args.in[3], *state_conv = args.in[4], *p_prompt = args.in[5], *p_sample = args.in[6],
                *norm_in = args.in[7], *w_in = args.in[8], *conv_w = args.in[9], *rel_bias = args.in[10], *norm_conv = args.in[11], *norm_att = args.in[12], *w_out = args.in[13],
                *ple_norm = args.in[14], *w_g = args.in[15], *w_p = args.in[16], *final_norm = args.in[17];
    bf16 *WinT = (bf16*)(ws + WS_WIN), *WoutT = (bf16*)(ws + WS_WOUT), *WgT = (bf16*)(ws + WS_WG), *WpT = (bf16*)(ws + WS_WP), *PB = (bf16*)(ws + WS_PB), *KC = (bf16*)(ws + WS_KC), *VC = (bf16*)(ws + WS_VC),
         *XN = (bf16*)(ws + WS_XN), *YN = (bf16*)(ws + WS_XN), *Z = (bf16*)(ws + WS_Z), *X1N = (bf16*)(ws + WS_X1N), *PP = (bf16*)(ws + WS_PP);
    float *SS1 = (float*)(ws + WS_SS1), *SS2 = (float*)(ws + WS_SS2);
    const int lo = args.ph_lo, hi = args.ph_hi;
#ifndef PH_MASK
#define PH_MASK 63
#endif
#define IN(k) (((PH_MASK >> (k)) & 1) && lo <= (k) && (k) < hi)
#define TIDS() int tid_ = threadIdx.x; asm volatile("" : "+v"(tid_)); const int tid = tid_, lane = tid & 63, wave = __builtin_amdgcn_readfirstlane(tid >> 6); (void)tid; (void)lane; (void)wave
#define SEAM(k) do { if (IN(k) && IN((k) + 1)) grid.sync(); } while (0)

    if (IN(0)) {
        TIDS();
        LAS float* scr = (LAS float*)(lds + wave * 16384);
        const int gw = vcu * NWAVES + wave, NGW = G * NWAVES;
        constexpr int I_IN = (DM / 64) * (DIN / 32), I_O = (DM / 64) * (DM / 32), I_P = (DPLE / 64) * (DM / 32), NITEMS = I_IN + 2 * I_O + I_P;
        for (int it = gw; it < NITEMS; it += NGW) {
            int r = it;
            if (r < I_IN) { p0_transpose_item(w_in, DM, DIN, WinT, scr, r, lane); continue; } r -= I_IN;
            if (r < I_O) { p0_transpose_item(w_out, DM, DM, WoutT, scr, r, lane); continue; } r -= I_O;
            if (r < I_O) { p0_transpose_item(w_g, DM, DM, WgT, scr, r, lane); continue; } r -= I_O;
            p0_transpose_item(w_p, DPLE, DM, WpT, scr, r, lane);
        }
        for (int mrow = gw; mrow < TT; mrow += NGW) {
            const float* xr = mrow < TP ? x_prompt + (size_t)mrow * DM : x_sample + (size_t)(mrow - TP) * DM;
            rms_row_to_bf16(xr, norm_in, XN + (size_t)mrow * DM, lane);
        }
        const size_t gtid = (size_t)vcu * (NWAVES * 64) + tid, gth = (size_t)G * (NWAVES * 64);
        cvt_stream(p_prompt, PB, (size_t)TP * DPLE, gtid, gth);
        cvt_stream(p_sample, PB + (size_t)TP * DPLE, (size_t)TS * DPLE, gtid, gth);
        cvt_stream(cache_k, KC, (size_t)DB * KVW * 512, gtid, gth);
        cvt_stream(cache_v, VC, (size_t)DB * KVW * 512, gtid, gth);
        __syncthreads();
    }
    SEAM(0);
    if (IN(1)) {
        pg8::Gemm g{XN, WinT, TT, DIN, DM}; pg8::StaticOrder S; S.init(TT, DIN, G, bx);
        pg8::EpiZ E{Z, out};
        pg8::gemm_phase<pg8::EpiZ, pg8::StaticOrder, true, true>(lds, g, S, E);
    }
    SEAM(1);
    if (IN(2)) {
        TIDS();
        __syncthreads();
        { LAS float* b2 = (LAS float*)(lds + wave * P2_WAVE_BYTES + P2_BIAS_OFF);
          for (int i = lane; i < 257; i += 64) b2[i] = rel_bias[wave * 257 + i] * 1.4426950408889634f; }
        __syncthreads();
        for (int u = vcu; u < 512 + DB; u += G) {
            P2Unit U;
            if (u < 512) { const int b = u >> 6, c = u & 63; const long row0 = (long)b * SEQ + 64 * c;
                U.zq = Z + row0 * DIN; U.kpast = Z + (row0 - 512) * DIN + 2560; U.vpast = Z + (row0 - 512) * DIN + 3072; U.past_pitch = DIN; U.kb0 = 16 - 2 * (c < 8 ? c : 8); U.ntok = 64;
                U.hist = c > 0 ? 1 : 0; U.sconv = nullptr; U.cstate = (c == 63) ? out + pg8::OFF_CP + b * 1024 : nullptr; U.yn = YN + row0 * DM;
                p2_unit<2>(U, lds, wave, lane, conv_w, norm_conv, norm_att);
            } else { const int b = u - 512; const long row0 = (long)TP + 32 * b;
                U.zq = Z + row0 * DIN; U.kpast = KC + (long)b * KVW * 512; U.vpast = VC + (long)b * KVW * 512; U.past_pitch = 512; U.kb0 = 0; U.ntok = 32;
                U.hist = 2; U.sconv = state_conv + b * 1024; U.cstate = out + pg8::OFF_CS + b * 1024; U.yn = YN + row0 * DM;
                p2_unit<1>(U, lds, wave, lane, conv_w, norm_conv, norm_att);
            }
        }
    }
    SEAM(2);
    if (IN(3)) {
        { pg8::Gemm g{YN, WoutT, TT, DM, DM}; pg8::StaticOrder S; S.init(TT, DM, G, bx);
          pg8::EpiX1 E{x_prompt, x_sample, out, X1N, ple_norm, SS1};
          pg8::gemm_phase<pg8::EpiX1, pg8::StaticOrder, true, true>(lds, g, S, E); }
        { pg8::Gemm g{PB, WpT, TT, DM, DPLE}; pg8::StaticOrder S; S.init(TT, DM, G, G - 1 - bx);
          pg8::EpiPlain E{PP, DM};
          pg8::gemm_phase<pg8::EpiPlain, pg8::StaticOrder, true, true>(lds, g, S, E); }
    }
    SEAM(3);
    if (IN(4)) {
        pg8::Gemm g{X1N, WgT, TT, DM, DM}; pg8::StaticOrder S; S.init(TT, DM, G, bx);
        pg8::EpiGate E{out, PP, SS1, SS2};
        pg8::gemm_phase<pg8::EpiGate, pg8::StaticOrder, true, true>(lds, g, S, E);
    }
    SEAM(4);
    if (IN(5)) {
        TIDS();
        const int gw = vcu * NWAVES + wave, NGW = G * NWAVES;
        f32x4 fg[4];
#pragma unroll
        for (int j = 0; j < 4; ++j) fg[j] = ((const f32x4*)final_norm)[lane + 64 * j];
        for (int mrow = gw; mrow < TT; mrow += NGW) {
            const f32x4* sp = (const f32x4*)(SS2 + (size_t)mrow * 16); const f32x4 s0 = sp[0], s1 = sp[1], s2 = sp[2], s3 = sp[3];
            const float tot = ((s0[0] + s0[1]) + (s0[2] + s0[3])) + ((s1[0] + s1[1]) + (s1[2] + s1[3])) + ((s2[0] + s2[1]) + (s2[2] + s2[3])) + ((s3[0] + s3[1]) + (s3[2] + s3[3]));
            const float r2 = 1.0f / sqrtf(tot * (1.0f / 1024.0f) + 1e-6f);
            f32x4* xr = (f32x4*)(out + (size_t)mrow * DM) + lane;
#pragma unroll
            for (int j = 0; j < 4; ++j) { f32x4 v = xr[64 * j]; v = v * r2 * fg[j]; xr[64 * j] = v; }
        }
    }
#undef IN
#undef SEAM
}

extern "C" void kernel_launch(void* const* d_in, const int* in_sizes, int n_in, void* d_out, int out_size, void* d_ws, size_t ws_size, hipStream_t stream) {
    static int grid = 0;
    if (grid == 0) {
        if (n_in != 18 || ws_size < WS_END) { fprintf(stderr, "kernel_launch: unexpected n_in %d / ws %zu\n", n_in, ws_size); grid = -1; return; }
        int dev = 0, cus = 0, per_cu = 0;
        hipGetDevice(&dev); hipDeviceGetAttribute(&cus, hipDeviceAttributeMultiprocessorCount, dev);
        if (hipFuncSetAttribute((const void*)fwd_kernel, hipFuncAttributeMaxDynamicSharedMemorySize, LDS_BYTES) != hipSuccess) { fprintf(stderr, "kernel_launch: hipFuncSetAttribute failed\n"); grid = -1; return; }
        if (hipOccupancyMaxActiveBlocksPerMultiprocessor(&per_cu, (const void*)fwd_kernel, NWAVES * 64, LDS_BYTES) != hipSuccess || per_cu < 1) { fprintf(stderr, "kernel_launch: occupancy query says %d\n", per_cu); per_cu = 1; }
        (void)hipGetLastError();
        grid = cus * (per_cu < 1 ? 1 : (per_cu > 1 ? 1 : per_cu));
        if (grid > 256) grid = 256;
    }
    if (grid < 0) return;
    Args a{};
    for (int i = 0; i < 18; ++i) a.in[i] = (const float*)d_in[i];
    a.out = (float*)d_out; a.ws = (unsigned char*)d_ws;
#if N_LAUNCH_MODE == 1
    a.ph_lo = 0; a.ph_hi = 6;
    void* kargs[] = {&a};
    hipError_t e = hipLaunchCooperativeKernel((const void*)fwd_kernel, dim3(grid), dim3(NWAVES * 64), kargs, LDS_BYTES, stream);
    if (e != hipSuccess) fprintf(stderr, "cooperative launch failed: %s (grid %d)\n", hipGetErrorString(e), grid);
#else
    for (int p = 0; p < 6; ++p) { a.ph_lo = p; a.ph_hi = p + 1; hipLaunchKernelGGL(fwd_kernel, dim3(grid), dim3(NWAVES * 64), LDS_BYTES, stream, a); }
#endif
}
```

```cpp
#include <hip/hip_runtime.h>
#include <hip/hip_cooperative_groups.h>
#include <cstdio>
#include <cstdint>
namespace cg = cooperative_groups;
namespace pg8 {
#define PG8_LAS __attribute__((address_space(3)))
typedef unsigned short bf16_t;
typedef short bf16x8 __attribute__((ext_vector_type(8)));
typedef float f32x4 __attribute__((ext_vector_type(4)));
typedef unsigned u32x4 __attribute__((ext_vector_type(4)));
constexpr int BM = 256, BK = 64, HALF = 128, HTB = HALF * BK * 2  , STAGE_BYTES = 8 * HTB, NXCD = 8, WGM = 8;

__host__ __device__ __forceinline__ int lds_byte(int r, int c) { const int st = (r >> 4) * 2 + (c >> 5), rr = r & 15, cc = c & 31, ob = rr * 64 + cc * 2; return st * 1024 + (ob ^ (((ob >> 9) & 1) << 5)); }
__host__ __device__ __forceinline__ void stage_rc(int b, int& R, int& C) { const int st = b / 1024, sb = b % 1024, swz = sb ^ (((sb >> 9) & 1) << 5); R = (st >> 1) * 16 + swz / 64; C = (st & 1) * 32 + (swz % 64) / 2; }
__host__ __device__ __forceinline__ int perm32(int rho) { const int n = rho >> 4, i = rho & 15; return 8 * (i >> 2) + 4 * n + (i & 3); }

struct Unit { int pm, pn; };
struct Gemm { const bf16_t* A; const bf16_t* Bt; int M, N, K; };

struct StaticOrder {
    int nM, nN, nwg, G, c;
    __host__ __device__ void init(int M, int N, int G_, int c_) { nM = M / BM; nN = N / BM; nwg = nM * nN; G = G_; c = c_; }
    __host__ __device__ bool next(int i, Unit& u) const {
        const long L = (long)i * G + c; if (L >= nwg) return false;
        int wgid = (int)L; { const int q = nwg / NXCD, r = nwg % NXCD, xcd = wgid % NXCD, off = wgid / NXCD; wgid = (xcd < r ? xcd * (q + 1) : r * (q + 1) + (xcd - r) * q) + off; }
        const int nig = WGM * nN, gid = wgid / nig, fm = gid * WGM, gsz = (nM - fm) < WGM ? (nM - fm) : WGM;
        u.pm = fm + ((wgid % nig) % gsz); u.pn = (wgid % nig) / gsz; return true;
    }
    __device__ __forceinline__ void a_ready(const Unit&) const {}
    __device__ __forceinline__ void done(const Unit&) const {}
};

__device__ __forceinline__ unsigned cvt_pk_bf16(float lo, float hi) { unsigned r; asm volatile("v_cvt_pk_bf16_f32 %0, %1, %2" : "=v"(r) : "v"(lo), "v"(hi)); return r; }
typedef float f32x2 __attribute__((ext_vector_type(2)));
constexpr long OFF_YS = 33554432L, OFF_KP = 34603008L, OFF_VP = 36700160L, OFF_CP = 38797312L, OFF_KS = 38805504L, OFF_VS = 39329792L, OFF_CS = 39854080L, OUT_TOTAL = 39886848L;
constexpr float RMS_EPS = 1e-6f;
struct EpiZ {
    static constexpr bool PERM = true, AFTER_DRAIN = false;
    bf16_t* Z; float* out;
    __device__ __forceinline__ void operator()(const f32x4 (&acc)[2][2][4][2], const Unit& u, int wr, int wc, int fr, int fq) const {
        const int row0 = u.pm * BM + wr * 64 + fr, col0 = u.pn * BM + wc * 32 + 8 * fq;
        const bool kv = (u.pn >= 10 && u.pn < 14), samp = u.pm >= 128, st = kv && (samp || (u.pm & 15) >= 14), isk = u.pn < 12;
        const int rowsub = samp ? 32768 : 3584 * (u.pm / 16 + 1), colsub = isk ? 2560 : 3072;
        float* sp = out + (samp ? (isk ? OFF_KS : OFF_VS) : (isk ? OFF_KP : OFF_VP));
#pragma unroll
        for (int ai = 0; ai < 2; ++ai)
#pragma unroll
            for (int m = 0; m < 4; ++m) { const int row = row0 + ai * HALF + m * 16; bf16_t* rowp = Z + (size_t)row * 4096 + col0;
#pragma unroll
                for (int bj = 0; bj < 2; ++bj) { const f32x4 v0 = acc[ai][bj][m][0], v1 = acc[ai][bj][m][1];
                    u32x4 w; w.x = cvt_pk_bf16(v0[0], v0[1]); w.y = cvt_pk_bf16(v0[2], v0[3]); w.z = cvt_pk_bf16(v1[0], v1[1]); w.w = cvt_pk_bf16(v1[2], v1[3]);
                    *(u32x4*)(rowp + bj * HALF) = w;
                    if (st) { float* d = sp + (size_t)(row - rowsub) * 512 + (col0 + bj * HALF - colsub); *(f32x4*)d = v0; *(f32x4*)(d + 4) = v1; } } }
    }
};
struct EpiPlain {
    static constexpr bool PERM = true, AFTER_DRAIN = false;
    bf16_t* O; int ldc;
    __device__ __forceinline__ void operator()(const f32x4 (&acc)[2][2][4][2], const Unit& u, int wr, int wc, int fr, int fq) const {
        const int row0 = u.pm * BM + wr * 64 + fr, col0 = u.pn * BM + wc * 32 + 8 * fq;
#pragma unroll
        for (int ai = 0; ai < 2; ++ai)
#pragma unroll
            for (int m = 0; m < 4; ++m) { bf16_t* rowp = O + (size_t)(row0 + ai * HALF + m * 16) * ldc + col0;
#pragma unroll
                for (int bj = 0; bj < 2; ++bj) { const f32x4 v0 = acc[ai][bj][m][0], v1 = acc[ai][bj][m][1];
                    u32x4 w; w.x = cvt_pk_bf16(v0[0], v0[1]); w.y = cvt_pk_bf16(v0[2], v0[3]); w.z = cvt_pk_bf16(v1[0], v1[1]); w.w = cvt_pk_bf16(v1[2], v1[3]);
                    *(u32x4*)(rowp + bj * HALF) = w; } }
    }
};
struct EpiX1 {
    static constexpr bool PERM = true, AFTER_DRAIN = false;
    const float* xp; const float* xs; float* outx; bf16_t* X1N; const float* g; float* SS;
    __device__ __forceinline__ void operator()(const f32x4 (&acc)[2][2][4][2], const Unit& u, int wr, int wc, int fr, int fq) const {
        const int row0 = u.pm * BM + wr * 64 + fr, col0 = u.pn * BM + wc * 32 + 8 * fq;
        const float* xb = u.pm < 128 ? xp : xs - (size_t)32768 * 1024;
#pragma unroll
        for (int ai = 0; ai < 2; ++ai)
#pragma unroll
            for (int m = 0; m < 4; ++m) { const int row = row0 + ai * HALF + m * 16;
                float ss = 0.f;
#pragma unroll
                for (int bj = 0; bj < 2; ++bj) { const size_t off = (size_t)row * 1024 + col0 + bj * HALF;
                    const f32x4 v0 = acc[ai][bj][m][0] + *(const f32x4*)(xb + off), v1 = acc[ai][bj][m][1] + *(const f32x4*)(xb + off + 4);
                    *(f32x4*)(outx + off) = v0; *(f32x4*)(outx + off + 4) = v1;
                    ss += (v0[0] * v0[0] + v0[1] * v0[1]) + (v0[2] * v0[2] + v0[3] * v0[3]) + (v1[0] * v1[0] + v1[1] * v1[1]) + (v1[2] * v1[2] + v1[3] * v1[3]);
                    const f32x4 a = v0 * *(const f32x4*)(g + col0 + bj * HALF), b = v1 * *(const f32x4*)(g + col0 + bj * HALF + 4);
                    u32x4 w; w.x = cvt_pk_bf16(a[0], a[1]); w.y = cvt_pk_bf16(a[2], a[3]); w.z = cvt_pk_bf16(b[0], b[1]); w.w = cvt_pk_bf16(b[2], b[3]);
                    *(u32x4*)(X1N + off) = w; }
                ss += __shfl_xor(ss, 16); ss += __shfl_xor(ss, 32);
                if (fq == 0) SS[(size_t)row * 16 + u.pn * 4 + wc] = ss; }
    }
};
__device__ __forceinline__ float bf_lo(unsigned w) { return __uint_as_float(w << 16); }
__device__ __forceinline__ float bf_hi(unsigned w) { return __uint_as_float(w & 0xffff0000u); }
struct EpiGate {
    static constexpr bool PERM = true, AFTER_DRAIN = false;
    float* outx; const bf16_t* PP; const float* SS1; float* SS2;
    __device__ __forceinline__ void operator()(const f32x4 (&acc)[2][2][4][2], const Unit& u, int wr, int wc, int fr, int fq) const {
        const int row0 = u.pm * BM + wr * 64 + fr, col0 = u.pn * BM + wc * 32 + 8 * fq;
#pragma unroll
        for (int ai = 0; ai < 2; ++ai)
#pragma unroll
            for (int m = 0; m < 4; ++m) { const int row = row0 + ai * HALF + m * 16;
                const f32x4* sp = (const f32x4*)(SS1 + (size_t)row * 16); const f32x4 s0 = sp[0], s1 = sp[1], s2 = sp[2], s3 = sp[3];
                const float tot = ((s0[0] + s0[1]) + (s0[2] + s0[3])) + ((s1[0] + s1[1]) + (s1[2] + s1[3])) + ((s2[0] + s2[1]) + (s2[2] + s2[3])) + ((s3[0] + s3[1]) + (s3[2] + s3[3]));
                const float r1 = -1.4426950408889634f / sqrtf(tot * (1.0f / 1024.0f) + RMS_EPS);
                float ss = 0.f;
#pragma unroll
                for (int bj = 0; bj < 2; ++bj) { const size_t off = (size_t)row * 1024 + col0 + bj * HALF;
                    const f32x4 x0 = *(const f32x4*)(outx + off), x1 = *(const f32x4*)(outx + off + 4); const u32x4 pw = *(const u32x4*)(PP + off);
                    const f32x4 a0 = acc[ai][bj][m][0] * r1, a1 = acc[ai][bj][m][1] * r1;
                    f32x4 g0, g1;
#pragma unroll
                    for (int e = 0; e < 4; ++e) { g0[e] = __builtin_amdgcn_rcpf(1.0f + __builtin_amdgcn_exp2f(a0[e])); g1[e] = __builtin_amdgcn_rcpf(1.0f + __builtin_amdgcn_exp2f(a1[e])); }
                    const f32x4 p0 = {bf_lo(pw.x), bf_hi(pw.x), bf_lo(pw.y), bf_hi(pw.y)}, p1 = {bf_lo(pw.z), bf_hi(pw.z), bf_lo(pw.w), bf_hi(pw.w)};
                    const f32x4 v0 = x0 + g0 * p0, v1 = x1 + g1 * p1;
                    *(f32x4*)(outx + off) = v0; *(f32x4*)(outx + off + 4) = v1;
                    ss += (v0[0] * v0[0] + v0[1] * v0[1]) + (v0[2] * v0[2] + v0[3] * v0[3]) + (v1[0] * v1[0] + v1[1] * v1[1]) + (v1[2] * v1[2] + v1[3] * v1[3]); }
                ss += __shfl_xor(ss, 16); ss += __shfl_xor(ss, 32);
                if (fq == 0) SS2[(size_t)row * 16 + u.pn * 4 + wc] = ss; }
    }
};

template <class Epi, class Sched, bool ALIGN_EPI = false, bool SP2 = false>
__device__ __forceinline__ void gemm_phase(PG8_LAS unsigned char* lds, const Gemm g, const Sched& S, const Epi& E) {
    int tid_ = threadIdx.x; asm volatile("" : "+v"(tid_));
    const int tid = tid_, wid = __builtin_amdgcn_readfirstlane(tid >> 6), lane = tid & 63, wr = wid >> 2, wc = wid & 3, fr = lane & 15, fq = lane >> 4;
    const int K = g.K, nt = K / BK;
    unsigned voffA[2], voffB[2];
#pragma unroll
    for (int i = 0; i < 2; ++i) { int R, C; stage_rc(tid * 16 + i * 8192, R, C); const int Rb = Epi::PERM ? ((R & ~31) + perm32(R & 31)) : R;
        voffA[i] = (unsigned)(R * K + C) * 2u; voffB[i] = (unsigned)(Rb * K + C) * 2u; }
    const size_t kstep = (size_t)(BK * 2);
    const size_t hstep = (size_t)HALF * K * 2;
    const size_t tstep = 2 * hstep;
    const unsigned ldsw = (unsigned)wid * 1024u;
    const int aoff = lds_byte(wr * 64 + fr, fq * 8), boff = lds_byte(wc * 32 + fr, fq * 8);
#define PG8_SA(b, h) (((b) * 2 + (h)) * HTB)
#define PG8_SB(b, h) ((4 + (b) * 2 + (h)) * HTB)
#define PG8_STAGE(bufoff, gbase, voff) do { _Pragma("unroll") for (int _i = 0; _i < 2; ++_i) \
        __builtin_amdgcn_global_load_lds((const unsigned*)((const char*)(gbase) + (voff)[_i]), (PG8_LAS unsigned*)(lds + (bufoff) + ldsw + _i * 8192), 16, 0, 0); } while (0)
#define PG8_LDA(dst, b, h) do { _Pragma("unroll") for (int m = 0; m < 4; ++m) _Pragma("unroll") for (int k = 0; k < 2; ++k) dst[m][k] = *(const PG8_LAS bf16x8*)(lds + PG8_SA(b, h) + aoff + m * 2048 + k * 1024); } while (0)
#define PG8_LDB(dst, b, h) do { _Pragma("unroll") for (int n = 0; n < 2; ++n) _Pragma("unroll") for (int k = 0; k < 2; ++k) dst[n][k] = *(const PG8_LAS bf16x8*)(lds + PG8_SB(b, h) + boff + n * 2048 + k * 1024); } while (0)
#define PG8_MMA(ai, bj, At, Bt) do { __builtin_amdgcn_s_setprio(1); _Pragma("unroll") for (int m = 0; m < 4; ++m) _Pragma("unroll") for (int n = 0; n < 2; ++n) _Pragma("unroll") for (int k = 0; k < 2; ++k) \
        acc[ai][bj][m][n] = __builtin_amdgcn_mfma_f32_16x16x32_bf16(Bt[n][k], At[m][k], acc[ai][bj][m][n], 0, 0, 0); __builtin_amdgcn_s_setprio(0); } while (0)
#define PG8_WAIT_V(n) asm volatile("s_waitcnt vmcnt(" #n ")" ::: "memory")
#define PG8_WAIT_L(n) asm volatile("s_waitcnt lgkmcnt(" #n ")" ::: "memory")
#define PG8_BAR __builtin_amdgcn_s_barrier()
#define PG8_SCHED __builtin_amdgcn_sched_barrier(0)
    Unit cur, nxt; int ui = 0;
    if (!S.next(0, cur)) return;
    f32x4 acc[2][2][4][2];
#pragma unroll
    for (int a = 0; a < 2; ++a)
#pragma unroll
        for (int b = 0; b < 2; ++b)
#pragma unroll
            for (int m = 0; m < 4; ++m)
#pragma unroll
                for (int n = 0; n < 2; ++n) acc[a][b][m][n] = (f32x4){0.f, 0.f, 0.f, 0.f};
    bf16x8 At[4][2], B0[2][2], B1[2][2];
    const char* cA = (const char*)g.A + (size_t)cur.pm * tstep; const char* cB = (const char*)g.Bt + (size_t)cur.pn * tstep;
    S.a_ready(cur);
    if constexpr (SP2) {
        PG8_STAGE(PG8_SB(0, 0), cB, voffB); PG8_STAGE(PG8_SB(0, 1), cB + hstep, voffB); PG8_STAGE(PG8_SA(0, 0), cA, voffA); PG8_STAGE(PG8_SA(0, 1), cA + hstep, voffA);
        if (wr == 1) PG8_BAR;
        PG8_WAIT_V(2); PG8_BAR;
        PG8_STAGE(PG8_SB(1, 0), cB + kstep, voffB); PG8_STAGE(PG8_SA(1, 0), cA + kstep, voffA); PG8_STAGE(PG8_SB(1, 1), cB + hstep + kstep, voffB);
        PG8_WAIT_V(6); PG8_BAR;
    } else {
        PG8_STAGE(PG8_SB(0, 0), cB, voffB); PG8_STAGE(PG8_SA(0, 0), cA, voffA); PG8_STAGE(PG8_SB(0, 1), cB + hstep, voffB); PG8_STAGE(PG8_SA(0, 1), cA + hstep, voffA);
        if (wr == 1) PG8_BAR;
        PG8_WAIT_V(4); PG8_BAR;
        PG8_STAGE(PG8_SB(1, 0), cB + kstep, voffB); PG8_STAGE(PG8_SA(1, 0), cA + kstep, voffA); PG8_STAGE(PG8_SB(1, 1), cB + hstep + kstep, voffB);
        PG8_WAIT_V(6); PG8_BAR;
    }
    for (;;) {
        const bool has_next = S.next(ui + 1, nxt);
        const char* nA = has_next ? (const char*)g.A + (size_t)nxt.pm * tstep : cA; const char* nB = has_next ? (const char*)g.Bt + (size_t)nxt.pn * tstep : cB;
        for (int t = 0; t < nt; t += 2) {
            const bool last = (t == nt - 2);
            const char* a1 = cA + (size_t)(t + 1) * kstep;
            const char* a2 = last ? nA : cA + (size_t)(t + 2) * kstep; const char* b2 = last ? nB : cB + (size_t)(t + 2) * kstep;
            const char* a3 = a2 + kstep; const char* b3 = b2 + kstep;
            if (last && has_next) S.a_ready(nxt);
            if constexpr (SP2) {
            PG8_LDB(B0, 0, 0); PG8_LDB(B1, 0, 1); PG8_SCHED; PG8_LDA(At, 0, 0); PG8_STAGE(PG8_SA(1, 1), a1 + hstep, voffA);
            PG8_WAIT_V(8); PG8_WAIT_L(0); PG8_BAR; PG8_MMA(0, 0, At, B0); PG8_MMA(0, 1, At, B1); PG8_BAR; PG8_SCHED;
            PG8_LDA(At, 0, 1); PG8_STAGE(PG8_SB(0, 0), b2, voffB); PG8_STAGE(PG8_SB(0, 1), b2 + hstep, voffB); PG8_STAGE(PG8_SA(0, 0), a2, voffA);
            PG8_WAIT_V(8); PG8_WAIT_L(0); PG8_BAR; PG8_MMA(1, 0, At, B0); PG8_MMA(1, 1, At, B1); PG8_BAR; PG8_SCHED;
            PG8_LDB(B0, 1, 0); PG8_LDB(B1, 1, 1); PG8_SCHED; PG8_LDA(At, 1, 0); PG8_STAGE(PG8_SA(0, 1), a2 + hstep, voffA);
            PG8_WAIT_V(8); PG8_WAIT_L(0); PG8_BAR; PG8_MMA(0, 0, At, B0); PG8_MMA(0, 1, At, B1); PG8_BAR; PG8_SCHED;
            PG8_LDA(At, 1, 1); PG8_STAGE(PG8_SB(1, 0), b3, voffB); PG8_STAGE(PG8_SB(1, 1), b3 + hstep, voffB); PG8_STAGE(PG8_SA(1, 0), a3, voffA);
            PG8_WAIT_V(8); PG8_WAIT_L(0); PG8_BAR; PG8_MMA(1, 0, At, B0); PG8_MMA(1, 1, At, B1); PG8_BAR; PG8_SCHED;
            } else {
            PG8_LDB(B0, 0, 0); PG8_SCHED; PG8_LDA(At, 0, 0); PG8_STAGE(PG8_SA(1, 1), a1 + hstep, voffA);
            PG8_WAIT_L(8); PG8_BAR; PG8_WAIT_L(0); PG8_MMA(0, 0, At, B0); PG8_BAR; PG8_SCHED;
            PG8_LDB(B1, 0, 1); PG8_STAGE(PG8_SB(0, 0), b2, voffB);
            PG8_BAR; PG8_WAIT_L(0); PG8_MMA(0, 1, At, B1); PG8_BAR;
            PG8_LDA(At, 0, 1); PG8_STAGE(PG8_SA(0, 0), a2, voffA);
            PG8_BAR; PG8_WAIT_L(0); PG8_MMA(1, 0, At, B0); PG8_BAR; PG8_SCHED;
            PG8_STAGE(PG8_SB(0, 1), b2 + hstep, voffB);
            PG8_WAIT_V(6); PG8_BAR; PG8_MMA(1, 1, At, B1); PG8_BAR;
            PG8_LDB(B0, 1, 0); PG8_SCHED; PG8_LDA(At, 1, 0); PG8_STAGE(PG8_SA(0, 1), a2 + hstep, voffA);
            PG8_WAIT_L(8); PG8_BAR; PG8_WAIT_L(0); PG8_MMA(0, 0, At, B0); PG8_BAR; PG8_SCHED;
            PG8_LDB(B1, 1, 1); PG8_STAGE(PG8_SB(1, 0), b3, voffB);
            PG8_BAR; PG8_WAIT_L(0); PG8_MMA(0, 1, At, B1); PG8_BAR;
            PG8_LDA(At, 1, 1); PG8_STAGE(PG8_SA(1, 0), a3, voffA);
            PG8_BAR; PG8_WAIT_L(0); PG8_MMA(1, 0, At, B0); PG8_BAR; PG8_SCHED;
            PG8_STAGE(PG8_SB(1, 1), b3 + hstep, voffB);
            PG8_WAIT_V(6); PG8_BAR; PG8_MMA(1, 1, At, B1); PG8_BAR;
            }
        }
        if constexpr (ALIGN_EPI) { if (wr == 0) PG8_BAR; }
        if constexpr (!Epi::AFTER_DRAIN) { E(acc, cur, wr, wc, fr, fq); S.done(cur); }
        if (!has_next) break;
#pragma unroll
        for (int a = 0; a < 2; ++a)
#pragma unroll
            for (int b = 0; b < 2; ++b)
#pragma unroll
                for (int m = 0; m < 4; ++m)
#pragma unroll
                    for (int n = 0; n < 2; ++n) acc[a][b][m][n] = (f32x4){0.f, 0.f, 0.f, 0.f};
        cur = nxt; cA = nA; cB = nB; ++ui;
        if constexpr (ALIGN_EPI) { if (wr == 1) PG8_BAR; }
    }
    PG8_WAIT_V(0);
    if constexpr (!ALIGN_EPI) { if (wr == 0) PG8_BAR; }
    PG8_BAR;
    if constexpr (Epi::AFTER_DRAIN) { E.fused(acc, cur, wr, wc, fr, fq, lds, wid, lane); S.done(cur); }
#undef PG8_SA
#undef PG8_SB
#undef PG8_STAGE
#undef PG8_LDA
#undef PG8_LDB
#undef PG8_MMA
#undef PG8_WAIT_V
#undef PG8_WAIT_L
#undef PG8_BAR
#undef PG8_SCHED
}
}
#define LAS __attribute__((address_space(3)))
typedef unsigned short bf16;
typedef unsigned v4u __attribute__((ext_vector_type(4)));
typedef unsigned v2u __attribute__((ext_vector_type(2)));
typedef float f32x4 __attribute__((ext_vector_type(4)));
typedef float f32x16 __attribute__((ext_vector_type(16)));
typedef short bf16x8 __attribute__((ext_vector_type(8)));
typedef short s16x4 __attribute__((ext_vector_type(4)));
typedef short v4i16_t __attribute__((ext_vector_type(4)));
typedef float f32x2_t __attribute__((ext_vector_type(2)));
typedef __bf16 bf16x2_t __attribute__((ext_vector_type(2)));
#define LDS_WAIT() asm volatile("s_waitcnt lgkmcnt(0)" ::: "memory")
__device__ __forceinline__ unsigned pk2(float lo, float hi) { f32x2_t v = {lo, hi}; bf16x2_t b = __builtin_convertvector(v, bf16x2_t); return __builtin_bit_cast(unsigned, b); }
__device__ __forceinline__ float blo(unsigned w) { return __uint_as_float(w << 16); }
__device__ __forceinline__ float bhi(unsigned w) { return __uint_as_float(w & 0xffff0000u); }
__device__ __forceinline__ float wave_sum(float v) {
#pragma unroll
    for (int o = 1; o < 64; o <<= 1) v += __shfl_xor(v, o);
    return v;
}
__device__ __forceinline__ float silu_f(float x) { return x * __builtin_amdgcn_rcpf(1.0f + __builtin_amdgcn_exp2f(-1.4426950408889634f * x)); }

constexpr int NWAVES = 8;
constexpr int DM = 1024, TP = 32768, TS = 1024, TT = TP + TS, DIN = 4096, DPLE = 256, SEQ = 4096, NB = 8, DB = 32, DSEQ = 32, KVW = 512;
constexpr size_t MiB = 1u << 20;
constexpr size_t WS_WIN = 1 * MiB, WS_WOUT = 9 * MiB, WS_WG = 11 * MiB, WS_WP = 13 * MiB, WS_SS1 = 14 * MiB, WS_SS2 = 17 * MiB, WS_PB = 20 * MiB, WS_KC = 37 * MiB, WS_VC = 53 * MiB,
                 WS_XN = 70 * MiB  , WS_Z = 136 * MiB, WS_X1N = 136 * MiB  , WS_PP = 202 * MiB, WS_END = 400 * MiB;
constexpr int LDS_BYTES = 147456, RING_BYTES = 131072;

struct Args { const float* in[18]; float* out; unsigned char* ws; };

__device__ __forceinline__ void p0_transpose_item(const float* W, int K, int N, bf16* WT, LAS float* scr, int item, int lane) {
    const int nblk = N / 32, kb = item / nblk, nb = item % nblk, k0 = 64 * kb, n0 = 32 * nb;
#pragma unroll 8
    for (int i = 0; i < 32; ++i) { const int kk = 2 * i + (lane >> 5); scr[kk * 33 + (lane & 31)] = W[(size_t)(k0 + kk) * N + n0 + (lane & 31)]; }
    LDS_WAIT(); asm volatile("" ::: "memory");
    const int c = lane & 7;
#pragma unroll
    for (int j = 0; j < 4; ++j) { const int n = (lane >> 3) + 8 * j; const LAS float* s = scr + (8 * c) * 33 + n;
        v4u o; o.x = pk2(s[0 * 33], s[1 * 33]); o.y = pk2(s[2 * 33], s[3 * 33]); o.z = pk2(s[4 * 33], s[5 * 33]); o.w = pk2(s[6 * 33], s[7 * 33]);
        *(v4u*)(WT + (size_t)(n0 + n) * K + k0 + 8 * c) = o; }
    LDS_WAIT(); asm volatile("" ::: "memory");
}
__device__ __forceinline__ void rms_row_to_bf16(const float* xrow, const float* g, bf16* orow, int lane) {
    const f32x4* xr = (const f32x4*)xrow + lane; const f32x4* gr = (const f32x4*)g + lane;
    f32x4 v[4]; float s = 0.f;
#pragma unroll
    for (int j = 0; j < 4; ++j) { v[j] = xr[64 * j]; s += (v[j].x * v[j].x + v[j].y * v[j].y) + (v[j].z * v[j].z + v[j].w * v[j].w); }
    const float rstd = 1.f / sqrtf(wave_sum(s) * (1.f / DM) + 1e-6f);
    v2u* o8 = (v2u*)orow + lane;
#pragma unroll
    for (int j = 0; j < 4; ++j) { const f32x4 gg = gr[64 * j]; v2u w; w.x = pk2(v[j].x * rstd * gg.x, v[j].y * rstd * gg.y); w.y = pk2(v[j].z * rstd * gg.z, v[j].w * rstd * gg.w); o8[64 * j] = w; }
}
__device__ __forceinline__ void cvt_stream(const float* src, bf16* dst, size_t n, size_t gtid, size_t gthreads) {
    for (size_t i = gtid * 8; i < n; i += gthreads * 8) { const f32x4 a = *(const f32x4*)(src + i), b = *(const f32x4*)(src + i + 4);
        v4u w; w.x = pk2(a.x, a.y); w.y = pk2(a.z, a.w); w.z = pk2(b.x, b.y); w.w = pk2(b.z, b.w); *(v4u*)(dst + i) = w; }
}

constexpr int VPITCH = 144;
constexpr int P2_WAVE_BYTES = 8192, P2_BIAS_OFF = 32 * VPITCH  , P2_SSA_OFF = 65536, P2_SSC_OFF = 65536 + 2048;
#define MFMA32(a, b, c) __builtin_amdgcn_mfma_f32_32x32x16_bf16((a), (b), (c), 0, 0, 0)
__device__ __forceinline__ s16x4 vtr(const LAS unsigned char* p) { return __builtin_bit_cast(s16x4, __builtin_amdgcn_ds_read_tr16_b64_v4i16((LAS v4i16_t*)p)); }

struct P2Unit {
    const bf16* zq;
    const bf16* kpast;
    const bf16* vpast;
    int past_pitch;
    int kb0;
    int ntok;
    int hist;
    const float* sconv;
    float* cstate;
    bf16* yn;
};

template <int NQB>
__device__ __forceinline__ void attn_wave(const P2Unit& U, int h, int lane, LAS unsigned char* vbuf, const LAS float* bias2, f32x16 (&o)[NQB][2], float (&linv)[NQB]) {
    const int r = lane & 31, hh = lane >> 5;
    bf16x8 qf[NQB][4];
#pragma unroll
    for (int qb = 0; qb < NQB; ++qb)
#pragma unroll
        for (int ks = 0; ks < 4; ++ks) qf[qb][ks] = *(const bf16x8*)(U.zq + (size_t)(32 * qb + r) * DIN + 2048 + h * 64 + 32 * hh + 8 * ks);
    float m[NQB], l[NQB];
#pragma unroll
    for (int qb = 0; qb < NQB; ++qb) { m[qb] = -1e30f; l[qb] = 0.f;
#pragma unroll
        for (int dh = 0; dh < 2; ++dh)
#pragma unroll
            for (int i = 0; i < 16; ++i) o[qb][dh][i] = 0.f; }
    const float bconst = bias2[256];
    const float C = 0.125f * 1.4426950408889634f;
    const int i16 = lane & 15, tq = i16 >> 2, tp = i16 & 3, blk = (lane >> 4) & 1;
    const LAS unsigned char* trb = vbuf + (4 * hh + tq) * VPITCH + 8 * (4 * blk + tp);
    for (int kb = U.kb0; kb < 16 + NQB; ++kb) {
        const bool past = kb < 16;
        const int pitch = past ? U.past_pitch : DIN;
        const bf16* kp = (past ? U.kpast + (size_t)(32 * kb) * U.past_pitch : U.zq + (size_t)(32 * (kb - 16)) * DIN + 2560) + h * 64;
        const bf16* vp = (past ? U.vpast + (size_t)(32 * kb) * U.past_pitch : U.zq + (size_t)(32 * (kb - 16)) * DIN + 3072) + h * 64;
        const int kbase = past ? -512 + 32 * kb : 32 * (kb - 16);
        bf16x8 kf[4]; v4u vv[4];
#pragma unroll
        for (int ks = 0; ks < 4; ++ks) kf[ks] = *(const bf16x8*)(kp + (size_t)r * pitch + 32 * hh + 8 * ks);
#pragma unroll
        for (int i = 0; i < 4; ++i) vv[i] = *(const v4u*)(vp + (size_t)(lane >> 1) * pitch + 32 * (lane & 1) + 8 * i);
        asm volatile("" ::: "memory");
#pragma unroll
        for (int i = 0; i < 4; ++i) *(LAS v4u*)(vbuf + (lane >> 1) * VPITCH + 64 * (lane & 1) + 16 * i) = vv[i];
        f32x16 s[NQB];
#pragma unroll
        for (int qb = 0; qb < NQB; ++qb) {
#pragma unroll
            for (int i = 0; i < 16; ++i) s[qb][i] = 0.f;
#pragma unroll
            for (int ks = 0; ks < 4; ++ks) s[qb] = MFMA32(kf[ks], qf[qb][ks], s[qb]);
        }
        bf16x8 pf[NQB][2];
        const bool lookup = kb >= 12;
#pragma unroll
        for (int qb = 0; qb < NQB; ++qb) {
            if (lookup) { const int relbase = (32 * qb + r) - kbase - 4 * hh + 128;
#pragma unroll
                for (int i = 0; i < 16; ++i) { int idx = relbase - ((i & 3) + 8 * (i >> 2)); idx = idx < 0 ? 0 : (idx > 256 ? 256 : idx); s[qb][i] = s[qb][i] * C + bias2[idx]; }
            } else {
#pragma unroll
                for (int i = 0; i < 16; ++i) s[qb][i] = s[qb][i] * C + bconst;
            }
            float mx = s[qb][0];
#pragma unroll
            for (int i = 1; i < 16; ++i) mx = fmaxf(mx, s[qb][i]);
            mx = fmaxf(mx, __shfl_xor(mx, 32));
            const float mn = fmaxf(m[qb], mx), alpha = __builtin_amdgcn_exp2f(m[qb] - mn); m[qb] = mn;
            float sum = 0.f;
#pragma unroll
            for (int i = 0; i < 16; ++i) { s[qb][i] = __builtin_amdgcn_exp2f(s[qb][i] - mn); sum += s[qb][i]; }
            l[qb] = l[qb] * alpha + sum;
#pragma unroll
            for (int dh = 0; dh < 2; ++dh)
#pragma unroll
                for (int i = 0; i < 16; ++i) o[qb][dh][i] *= alpha;
#pragma unroll
            for (int st = 0; st < 2; ++st) { v4u w; w.x = pk2(s[qb][8 * st + 0], s[qb][8 * st + 1]); w.y = pk2(s[qb][8 * st + 2], s[qb][8 * st + 3]); w.z = pk2(s[qb][8 * st + 4], s[qb][8 * st + 5]); w.w = pk2(s[qb][8 * st + 6], s[qb][8 * st + 7]);
                pf[qb][st] = __builtin_bit_cast(bf16x8, w); }
        }
        asm volatile("" ::: "memory");
#pragma unroll
        for (int st = 0; st < 2; ++st)
#pragma unroll
            for (int dh = 0; dh < 2; ++dh) {
                const s16x4 lo = vtr(trb + (16 * st) * VPITCH + 64 * dh), hi = vtr(trb + (16 * st + 8) * VPITCH + 64 * dh);
                const bf16x8 vt = __builtin_shufflevector(lo, hi, 0, 1, 2, 3, 4, 5, 6, 7);
#pragma unroll
                for (int qb = 0; qb < NQB; ++qb) o[qb][dh] = MFMA32(vt, pf[qb][st], o[qb][dh]);
            }
        asm volatile("" ::: "memory");
    }
#pragma unroll
    for (int qb = 0; qb < NQB; ++qb) { const float lt = l[qb] + __shfl_xor(l[qb], 32); linv[qb] = 1.0f / lt; }
}

template <int NQB>
__device__ __forceinline__ void p2_unit(const P2Unit& U, LAS unsigned char* lds, int wave, int lane, const float* conv_w, const float* norm_conv, const float* norm_att) {
    LAS unsigned char* wl = lds + wave * P2_WAVE_BYTES;
    LAS float* ssA = (LAS float*)(lds + P2_SSA_OFF); LAS float* ssC = (LAS float*)(lds + P2_SSC_OFF);
    const int r = lane & 31, hh = lane >> 5, h = wave;
    f32x16 o[NQB][2]; float linv[NQB];
    attn_wave<NQB>(U, h, lane, wl, (const LAS float*)(wl + P2_BIAS_OFF), o, linv);
#pragma unroll
    for (int qb = 0; qb < NQB; ++qb) {
        const bf16* za = U.zq + (size_t)(32 * qb + r) * DIN + 3584 + h * 64 + 4 * hh;
        float ss = 0.f;
#pragma unroll
        for (int dh = 0; dh < 2; ++dh)
#pragma unroll
            for (int g = 0; g < 4; ++g) { const v2u zw = *(const v2u*)(za + 32 * dh + 8 * g);
                const float z0 = blo(zw.x), z1 = bhi(zw.x), z2 = blo(zw.y), z3 = bhi(zw.y);
                float a0 = o[qb][dh][4 * g + 0] * linv[qb] * silu_f(z0), a1 = o[qb][dh][4 * g + 1] * linv[qb] * silu_f(z1), a2 = o[qb][dh][4 * g + 2] * linv[qb] * silu_f(z2), a3 = o[qb][dh][4 * g + 3] * linv[qb] * silu_f(z3);
                o[qb][dh][4 * g + 0] = a0; o[qb][dh][4 * g + 1] = a1; o[qb][dh][4 * g + 2] = a2; o[qb][dh][4 * g + 3] = a3;
                ss += (a0 * a0 + a1 * a1) + (a2 * a2 + a3 * a3); }
        ss += __shfl_xor(ss, 32);
        if (hh == 0) ssA[(32 * qb + r) * 8 + h] = ss;
    }
    __syncthreads();
#pragma unroll
    for (int qb = 0; qb < NQB; ++qb) {
        const LAS f32x4* sp = (const LAS f32x4*)(ssA + (32 * qb + r) * 8); const f32x4 a = sp[0], b = sp[1];
        const float ra = 1.0f / sqrtf((((a.x + a.y) + (a.z + a.w)) + ((b.x + b.y) + (b.z + b.w))) * (1.0f / 512.0f) + 1e-6f);
        bf16* yr = U.yn + (size_t)(32 * qb + r) * DM + 512 + h * 64 + 4 * hh;
        const float* ga = norm_att + h * 64 + 4 * hh;
#pragma unroll
        for (int dh = 0; dh < 2; ++dh)
#pragma unroll
            for (int g = 0; g < 4; ++g) { const f32x4 gg = *(const f32x4*)(ga + 32 * dh + 8 * g);
                v2u w; w.x = pk2(o[qb][dh][4 * g + 0] * ra * gg.x, o[qb][dh][4 * g + 1] * ra * gg.y); w.y = pk2(o[qb][dh][4 * g + 2] * ra * gg.z, o[qb][dh][4 * g + 3] * ra * gg.w);
                *(v2u*)(yr + 32 * dh + 8 * g) = w; }
    }
    const int c0 = 64 * wave + 8 * (lane & 7), tg = lane >> 3;
    const bool active = 8 * tg < U.ntok;
    float yc[8][8];
    {
        float w0[8], w1[8], w2[8];
#pragma unroll
        for (int e = 0; e < 8; ++e) { w0[e] = conv_w[c0 + e]; w1[e] = conv_w[512 + c0 + e]; w2[e] = conv_w[1024 + c0 + e]; }
        float u2[8], u1[8];
#pragma unroll
        for (int e = 0; e < 8; ++e) { u2[e] = 0.f; u1[e] = 0.f; }
        if (active) {
            if (tg > 0 || U.hist == 1) {
                const bf16* zr = U.zq + ((long)(8 * tg) - 2) * DIN + c0;
                const v4u h2 = *(const v4u*)(zr), g2 = *(const v4u*)(zr + 1024), h1 = *(const v4u*)(zr + DIN), g1 = *(const v4u*)(zr + DIN + 1024);
                u2[0] = blo(h2.x) * blo(g2.x); u2[1] = bhi(h2.x) * bhi(g2.x); u2[2] = blo(h2.y) * blo(g2.y); u2[3] = bhi(h2.y) * bhi(g2.y);
                u2[4] = blo(h2.z) * blo(g2.z); u2[5] = bhi(h2.z) * bhi(g2.z); u2[6] = blo(h2.w) * blo(g2.w); u2[7] = bhi(h2.w) * bhi(g2.w);
                u1[0] = blo(h1.x) * blo(g1.x); u1[1] = bhi(h1.x) * bhi(g1.x); u1[2] = blo(h1.y) * blo(g1.y); u1[3] = bhi(h1.y) * bhi(g1.y);
                u1[4] = blo(h1.z) * blo(g1.z); u1[5] = bhi(h1.z) * bhi(g1.z); u1[6] = blo(h1.w) * blo(g1.w); u1[7] = bhi(h1.w) * bhi(g1.w);
            } else if (U.hist == 2) {
#pragma unroll
                for (int e = 0; e < 8; ++e) { u2[e] = U.sconv[c0 + e]; u1[e] = U.sconv[512 + c0 + e]; }
            }
        }
#pragma unroll
        for (int j = 0; j < 8; ++j) {
            float u0[8];
            if (active) {
                const bf16* zr = U.zq + (size_t)(8 * tg + j) * DIN + c0;
                const v4u hv = *(const v4u*)(zr), bv = *(const v4u*)(zr + 512), gv = *(const v4u*)(zr + 1024), zv = *(const v4u*)(zr + 1536);
                u0[0] = blo(hv.x) * blo(gv.x); u0[1] = bhi(hv.x) * bhi(gv.x); u0[2] = blo(hv.y) * blo(gv.y); u0[3] = bhi(hv.y) * bhi(gv.y);
                u0[4] = blo(hv.z) * blo(gv.z); u0[5] = bhi(hv.z) * bhi(gv.z); u0[6] = blo(hv.w) * blo(gv.w); u0[7] = bhi(hv.w) * bhi(gv.w);
                const float bb[8] = {blo(bv.x), bhi(bv.x), blo(bv.y), bhi(bv.y), blo(bv.z), bhi(bv.z), blo(bv.w), bhi(bv.w)};
                const float zz[8] = {blo(zv.x), bhi(zv.x), blo(zv.y), bhi(zv.y), blo(zv.z), bhi(zv.z), blo(zv.w), bhi(zv.w)};
                float ss = 0.f;
#pragma unroll
                for (int e = 0; e < 8; ++e) { const float cv = w0[e] * u2[e] + w1[e] * u1[e] + w2[e] * u0[e]; const float y = bb[e] * cv * silu_f(zz[e]); yc[j][e] = y; ss += y * y; }
                ss += __shfl_xor(ss, 1); ss += __shfl_xor(ss, 2); ss += __shfl_xor(ss, 4);
                if ((lane & 7) == 0) ssC[(8 * tg + j) * 8 + wave] = ss;
                if (U.cstate && j >= 6 && 8 * tg + 8 == U.ntok) { float* d = U.cstate + (j - 6) * 512 + c0; *(f32x4*)d = (f32x4){u0[0], u0[1], u0[2], u0[3]}; *(f32x4*)(d + 4) = (f32x4){u0[4], u0[5], u0[6], u0[7]}; }
            } else {
#pragma unroll
                for (int e = 0; e < 8; ++e) { u0[e] = 0.f; yc[j][e] = 0.f; }
            }
#pragma unroll
            for (int e = 0; e < 8; ++e) { u2[e] = u1[e]; u1[e] = u0[e]; }
        }
    }
    __syncthreads();
    if (active) {
        const f32x4 g0 = *(const f32x4*)(norm_conv + c0), g1 = *(const f32x4*)(norm_conv + c0 + 4);
#pragma unroll
        for (int j = 0; j < 8; ++j) {
            const LAS f32x4* sp = (const LAS f32x4*)(ssC + (8 * tg + j) * 8); const f32x4 a = sp[0], b = sp[1];
            const float rc = 1.0f / sqrtf((((a.x + a.y) + (a.z + a.w)) + ((b.x + b.y) + (b.z + b.w))) * (1.0f / 512.0f) + 1e-6f);
            v4u w; w.x = pk2(yc[j][0] * rc * g0.x, yc[j][1] * rc * g0.y); w.y = pk2(yc[j][2] * rc * g0.z, yc[j][3] * rc * g0.w);
            w.z = pk2(yc[j][4] * rc * g1.x, yc[j][5] * rc * g1.y); w.w = pk2(yc[j][6] * rc * g1.z, yc[j][7] * rc * g1.w);
            *(v4u*)(U.yn + (size_t)(8 * tg + j) * DM + c0) = w;
        }
    }
}
#define XB_TMO      128
#define XB_XCNT(j)  (256  + 64 * (j))
#define XB_XSUB(j)  (1280 + 64 * (j))
#define XB_XGEN(j)  (2304 + 64 * (j))
#define XB_TOP      3328
#define XB_TOPGEN   3392
#define XCD_BAR_WORDS 3456
#define XB_SPIN_CAP (1u << 18)

__device__ __forceinline__ unsigned xb_ld(unsigned* p)              { return __hip_atomic_load(p, __ATOMIC_RELAXED, __HIP_MEMORY_SCOPE_AGENT); }
__device__ __forceinline__ unsigned xb_add(unsigned* p, unsigned v) { return __hip_atomic_fetch_add(p, v, __ATOMIC_RELAXED, __HIP_MEMORY_SCOPE_AGENT); }
__device__ __forceinline__ unsigned xb_xcc_id() { return (unsigned)__builtin_amdgcn_s_getreg((3 << 11) | 20) & 0xFu; }
#define XB_SPIN(cond, bar) do { unsigned _sp = 0; while (cond) { __builtin_amdgcn_s_sleep(1); \
    if ((++_sp & 255u) == 0u) { if (xb_ld(&(bar)[XB_TMO])) break; if (_sp > XB_SPIN_CAP) { atomicAdd(&(bar)[XB_TMO], 1u); break; } } } } while (0)

struct XcdBarrier {
    unsigned* bar; unsigned x;
    volatile LAS unsigned* st;
};

__device__ __forceinline__ XcdBarrier xcd_barrier_post(unsigned* bar, volatile LAS unsigned* st) {
    XcdBarrier b; b.bar = bar; b.x = xb_xcc_id(); b.st = st;
    if (threadIdx.x == 0) (void)xb_add(&bar[XB_XCNT(b.x)], 1u);
    return b;
}
__device__ __forceinline__ void xcd_barrier_complete(unsigned* bar, unsigned x, unsigned& nloc, unsigned& nx) {
    const unsigned G = gridDim.x * gridDim.y * gridDim.z;
    unsigned sum, cnt, mine, sp = 0u;
    for (;;) {
        sum = 0u; cnt = 0u; mine = 0u;
#pragma unroll
        for (unsigned j = 0; j < 16; ++j) { const unsigned c = xb_ld(&bar[XB_XCNT(j)]); sum += c; cnt += (c > 0u) ? 1u : 0u; mine = (j == x) ? c : mine; }
        if (sum == G) break;
        __builtin_amdgcn_s_sleep(1);
        if ((++sp & 255u) == 0u) { if (xb_ld(&bar[XB_TMO])) break; if (sp > XB_SPIN_CAP) { atomicAdd(&bar[XB_TMO], 1u); break; } }
    }
    nloc = mine > 0u ? mine : 1u; nx = cnt > 0u ? cnt : 1u;
}

__device__ __forceinline__ void xcd_barrier(const XcdBarrier& b) {
    asm volatile("s_waitcnt vmcnt(0)" ::: "memory");
    __syncthreads();
    if (threadIdx.x == 0) {
        unsigned* bar = b.bar;
        __builtin_amdgcn_s_waitcnt(0);
        unsigned nloc = b.st[0], nx = b.st[1];
        if (nloc == 0u) { xcd_barrier_complete(bar, b.x, nloc, nx); b.st[0] = nloc; b.st[1] = nx; }
        const unsigned old = xb_add(&bar[XB_XSUB(b.x)], 1u);
        const unsigned gen = old / nloc;
        if (old + 1u == (gen + 1u) * nloc) {
            __builtin_amdgcn_fence(__ATOMIC_RELEASE, "agent");
            asm volatile("s_waitcnt vmcnt(0)" ::: "memory");
            const unsigned og = xb_add(&bar[XB_TOP], 1u);
            const unsigned tg = og / nx;
            if (og + 1u == (tg + 1u) * nx) xb_add(&bar[XB_TOPGEN], 1u);
            else XB_SPIN(xb_ld(&bar[XB_TOPGEN]) == tg, bar);
            __builtin_amdgcn_fence(__ATOMIC_ACQUIRE, "agent");
            xb_add(&bar[XB_XGEN(b.x)], 1u);
            asm volatile("s_waitcnt vmcnt(0)" ::: "memory");
        } else {
            XB_SPIN(xb_ld(&bar[XB_XGEN(b.x)]) == gen, bar);
            __builtin_amdgcn_fence(__ATOMIC_ACQUIRE, "agent");
            asm volatile("s_waitcnt vmcnt(0)" ::: "memory");
        }
    }
    __syncthreads();
}

#define PHASE_PROLOG() \
    int tid_ = threadIdx.x; asm volatile("" : "+v"(tid_)); const int tid = tid_, lane = tid & 63, wave = __builtin_amdgcn_readfirstlane(tid >> 6); (void)tid; (void)lane; (void)wave; \
    const int G = gridDim.x, bx = blockIdx.x; const int vcu = (G % 8 == 0) ? (bx % 8) * (G / 8) + bx / 8 : bx; (void)vcu; \
    const __attribute__((address_space(4))) Args* ka = (const __attribute__((address_space(4))) Args*)__builtin_amdgcn_kernarg_segment_ptr(); asm volatile("" : "+s"(ka)); \
    unsigned char* ws = ka->ws; float* out = ka->out; (void)out; \
    bf16 *WinT = (bf16*)(ws + WS_WIN), *WoutT = (bf16*)(ws + WS_WOUT), *WgT = (bf16*)(ws + WS_WG), *WpT = (bf16*)(ws + WS_WP), *PB = (bf16*)(ws + WS_PB), *KC = (bf16*)(ws + WS_KC), *VC = (bf16*)(ws + WS_VC), \
         *XN = (bf16*)(ws + WS_XN), *YN = (bf16*)(ws + WS_XN), *Z = (bf16*)(ws + WS_Z), *X1N = (bf16*)(ws + WS_X1N), *PP = (bf16*)(ws + WS_PP); \
    float *SS1 = (float*)(ws + WS_SS1), *SS2 = (float*)(ws + WS_SS2); \
    (void)WinT; (void)WoutT; (void)WgT; (void)WpT; (void)PB; (void)KC; (void)VC; (void)XN; (void)YN; (void)Z; (void)X1N; (void)PP; (void)SS1; (void)SS2
__device__ __forceinline__ void phase0(LAS unsigned char* lds) {
    PHASE_PROLOG();
    const float *x_prompt = ka->in[0], *x_sample = ka->in[1], *cache_k = ka->in[2], *cache_v = ka->in[3], *p_prompt = ka->in[5], *p_sample = ka->in[6], *norm_in = ka->in[7], *w_in = ka->in[8], *w_out = ka->in[13], *w_g = ka->in[15], *w_p = ka->in[16];
        LAS float* scr = (LAS float*)(lds + wave * 16384);
        const int gw = vcu * NWAVES + wave, NGW = G * NWAVES;
        constexpr int I_IN = (DM / 64) * (DIN / 32), I_O = (DM / 64) * (DM / 32), I_P = (DPLE / 64) * (DM / 32), NITEMS = I_IN + 2 * I_O + I_P;
        for (int it = gw; it < NITEMS; it += NGW) {
            int r = it;
            if (r < I_IN) { p0_transpose_item(w_in, DM, DIN, WinT, scr, r, lane); continue; } r -= I_IN;
            if (r < I_O) { p0_transpose_item(w_out, DM, DM, WoutT, scr, r, lane); continue; } r -= I_O;
            if (r < I_O) { p0_transpose_item(w_g, DM, DM, WgT, scr, r, lane); continue; } r -= I_O;
            p0_transpose_item(w_p, DPLE, DM, WpT, scr, r, lane);
        }
        for (int mrow = gw; mrow < TT; mrow += NGW) {
            const float* xr = mrow < TP ? x_prompt + (size_t)mrow * DM : x_sample + (size_t)(mrow - TP) * DM;
            rms_row_to_bf16(xr, norm_in, XN + (size_t)mrow * DM, lane);
        }
        const size_t gtid = (size_t)vcu * (NWAVES * 64) + tid, gth = (size_t)G * (NWAVES * 64);
        cvt_stream(p_prompt, PB, (size_t)TP * DPLE, gtid, gth);
        cvt_stream(p_sample, PB + (size_t)TP * DPLE, (size_t)TS * DPLE, gtid, gth);
        cvt_stream(cache_k, KC, (size_t)DB * KVW * 512, gtid, gth);
        cvt_stream(cache_v, VC, (size_t)DB * KVW * 512, gtid, gth);
        __syncthreads();
}
__device__ __forceinline__ void phase1(LAS unsigned char* lds) {
    PHASE_PROLOG();
        pg8::Gemm g{XN, WinT, TT, DIN, DM}; pg8::StaticOrder S; S.init(TT, DIN, G, bx);
        pg8::EpiZ E{Z, out};
        pg8::gemm_phase<pg8::EpiZ, pg8::StaticOrder, true, true>(lds, g, S, E);
}
__device__ __forceinline__ void phase2(LAS unsigned char* lds) {
    PHASE_PROLOG();
    const float *state_conv = ka->in[4], *conv_w = ka->in[9], *rel_bias = ka->in[10], *norm_conv = ka->in[11], *norm_att = ka->in[12];
        __syncthreads();
        { LAS float* b2 = (LAS float*)(lds + wave * P2_WAVE_BYTES + P2_BIAS_OFF);
          for (int i = lane; i < 257; i += 64) b2[i] = rel_bias[wave * 257 + i] * 1.4426950408889634f; }
        __syncthreads();
        for (int u = vcu; u < 512 + DB; u += G) {
            P2Unit U;
            if (u < 512) { const int b = u >> 6, c = u & 63; const long row0 = (long)b * SEQ + 64 * c;
                U.zq = Z + row0 * DIN; U.kpast = Z + (row0 - 512) * DIN + 2560; U.vpast = Z + (row0 - 512) * DIN + 3072; U.past_pitch = DIN; U.kb0 = 16 - 2 * (c < 8 ? c : 8); U.ntok = 64;
                U.hist = c > 0 ? 1 : 0; U.sconv = nullptr; U.cstate = (c == 63) ? out + pg8::OFF_CP + b * 1024 : nullptr; U.yn = YN + row0 * DM;
                p2_unit<2>(U, lds, wave, lane, conv_w, norm_conv, norm_att);
            } else { const int b = u - 512; const long row0 = (long)TP + 32 * b;
                U.zq = Z + row0 * DIN; U.kpast = KC + (long)b * KVW * 512; U.vpast = VC + (long)b * KVW * 512; U.past_pitch = 512; U.kb0 = 0; U.ntok = 32;
                U.hist = 2; U.sconv = state_conv + b * 1024; U.cstate = out + pg8::OFF_CS + b * 1024; U.yn = YN + row0 * DM;
                p2_unit<1>(U, lds, wave, lane, conv_w, norm_conv, norm_att);
            }
        }
}
__device__ __forceinline__ void phase3(LAS unsigned char* lds) {
    PHASE_PROLOG();
    const float *x_prompt = ka->in[0], *x_sample = ka->in[1], *ple_norm = ka->in[14];
        { pg8::Gemm g{YN, WoutT, TT, DM, DM}; pg8::StaticOrder S; S.init(TT, DM, G, bx);
          pg8::EpiX1 E{x_prompt, x_sample, out, X1N, ple_norm, SS1};
          pg8::gemm_phase<pg8::EpiX1, pg8::StaticOrder, true, true>(lds, g, S, E); }
        { int kple = DPLE; asm volatile("" : "+s"(kple));
          pg8::Gemm g{PB, WpT, TT, DM, kple}; pg8::StaticOrder S; S.init(TT, DM, G, G - 1 - bx);
          pg8::EpiPlain E{PP, DM};
          pg8::gemm_phase<pg8::EpiPlain, pg8::StaticOrder, true, true>(lds, g, S, E); }
}
__device__ __forceinline__ void phase4(LAS unsigned char* lds) {
    PHASE_PROLOG();
        pg8::Gemm g{X1N, WgT, TT, DM, DM}; pg8::StaticOrder S; S.init(TT, DM, G, bx);
        pg8::EpiGate E{out, PP, SS1, SS2};
        pg8::gemm_phase<pg8::EpiGate, pg8::StaticOrder, true, true>(lds, g, S, E);
}
__device__ __forceinline__ void phase5(LAS unsigned char* lds) {
    PHASE_PROLOG();
    const float *final_norm = ka->in[17];
        const int gw = vcu * NWAVES + wave, NGW = G * NWAVES;
        f32x4 fg[4];
#pragma unroll
        for (int j = 0; j < 4; ++j) fg[j] = ((const f32x4*)final_norm)[lane + 64 * j];
        for (int mrow = gw; mrow < TT; mrow += NGW) {
            const f32x4* sp = (const f32x4*)(SS2 + (size_t)mrow * 16); const f32x4 s0 = sp[0], s1 = sp[1], s2 = sp[2], s3 = sp[3];
            const float tot = ((s0[0] + s0[1]) + (s0[2] + s0[3])) + ((s1[0] + s1[1]) + (s1[2] + s1[3])) + ((s2[0] + s2[1]) + (s2[2] + s2[3])) + ((s3[0] + s3[1]) + (s3[2] + s3[3]));
            const float r2 = 1.0f / sqrtf(tot * (1.0f / 1024.0f) + 1e-6f);
            f32x4* xr = (f32x4*)(out + (size_t)mrow * DM) + lane;
#pragma unroll
            for (int j = 0; j < 4; ++j) { f32x4 v = xr[64 * j]; v = v * r2 * fg[j]; xr[64 * j] = v; }
        }
}

#ifndef PHASE_PROGRAM
#define PHASE_PROGRAM phase0(lds); GSYNC(); phase1(lds); GSYNC(); phase2(lds); GSYNC(); phase3(lds); GSYNC(); phase4(lds); GSYNC(); phase5(lds);
#endif
constexpr size_t WS_BAR = 0, BAR_BYTES = 16384;
__global__ void __launch_bounds__(NWAVES * 64) fwd_kernel(Args args) {
    extern __shared__ __attribute__((aligned(16))) unsigned char lds_raw[];
    LAS unsigned char* lds = (LAS unsigned char*)lds_raw;
    cg::grid_group grid = cg::this_grid();
    volatile LAS unsigned* bst = (volatile LAS unsigned*)(lds + RING_BYTES + 64);
    if (threadIdx.x < 2) bst[threadIdx.x] = 0u;
    __syncthreads();
    const XcdBarrier xbar = xcd_barrier_post((unsigned*)(args.ws + WS_BAR), bst);
    if (args.ws == nullptr) grid.sync();
#define GSYNC() xcd_barrier(xbar)
    PHASE_PROGRAM
#undef GSYNC
}

extern "C" void kernel_launch(void* const* d_in, const int* in_sizes, int n_in, void* d_out, int out_size, void* d_ws, size_t ws_size, hipStream_t stream) {
    static int grid = 0;
    if (grid == 0) {
        if (n_in != 18 || ws_size < WS_END) { fprintf(stderr, "kernel_launch: unexpected n_in %d / ws %zu\n", n_in, ws_size); grid = -1; return; }
        int dev = 0, cus = 0, per_cu = 0;
        hipGetDevice(&dev); hipDeviceGetAttribute(&cus, hipDeviceAttributeMultiprocessorCount, dev);
        if (hipFuncSetAttribute((const void*)fwd_kernel, hipFuncAttributeMaxDynamicSharedMemorySize, LDS_BYTES) != hipSuccess) { fprintf(stderr, "kernel_launch: hipFuncSetAttribute failed\n"); grid = -1; return; }
        if (hipOccupancyMaxActiveBlocksPerMultiprocessor(&per_cu, (const void*)fwd_kernel, NWAVES * 64, LDS_BYTES) != hipSuccess || per_cu < 1) { fprintf(stderr, "kernel_launch: occupancy query says %d\n", per_cu); per_cu = 1; }
        (void)hipGetLastError();
        grid = cus * (per_cu < 1 ? 1 : (per_cu > 1 ? 1 : per_cu));
        if (grid > 256) grid = 256;
    }
    if (grid < 0) return;
    if (hipMemsetAsync((char*)d_ws + WS_BAR, 0, BAR_BYTES, stream) != hipSuccess) { fprintf(stderr, "kernel_launch: memset failed\n"); return; }
    Args a{};
    for (int i = 0; i < 18; ++i) a.in[i] = (const float*)d_in[i];
    a.out = (float*)d_out; a.ws = (unsigned char*)d_ws;
    void* kargs[] = {&a};
    hipError_t e = hipLaunchCooperativeKernel((const void*)fwd_kernel, dim3(grid), dim3(NWAVES * 64), kargs, LDS_BYTES, stream);
    if (e != hipSuccess) fprintf(stderr, "cooperative launch failed: %s (grid %d)\n", hipGetErrorString(e), grid);
}
```
